# Optimizing an MI355X kernel written in HIP

```python
import jax, jax.numpy as jnp
from jax import lax
import numpy as np

D_MODEL = 1024
BATCH = 4
SEQ = 8192
DEPTH = 1

CHUNK = 64
SSM_HEADS = 16
SSM_HEAD_DIM = 64
SSM_INNER = SSM_HEADS * SSM_HEAD_DIM
SSM_GROUPS = 2
SSM_STATE = 128
CONV_WIDTH = 4
CONV_DIM = SSM_INNER + 2 * SSM_GROUPS * SSM_STATE
SSM_CHUNK = CHUNK
ATTN_HEADS = 16
ATTN_HEAD_DIM = 64
ATTN_INNER = ATTN_HEADS * ATTN_HEAD_DIM
LEFT_CHUNKS = 8
BAND = (LEFT_CHUNKS + 1) * CHUNK
MAX_REL_DIST = 128
N_REL = 2 * MAX_REL_DIST + 1
D_FF = 2816
FFN_RES_SCALE = 0.5
N_BRANCHES = 2
RMS_EPS = 1e-6
IN_SPLIT_SIZES = (SSM_INNER, CONV_DIM, SSM_HEADS, ATTN_INNER, ATTN_INNER, ATTN_INNER, N_BRANCHES * D_MODEL)
IN_PROJ_DIM = SSM_INNER + CONV_DIM + SSM_HEADS + 3 * ATTN_INNER + N_BRANCHES * D_MODEL

kernel_name = "hybrid_ssd_chunkattn_macaron"


def rmsnorm(x, w):
    xf = x.astype(jnp.float32)
    y = xf * lax.rsqrt(jnp.mean(xf * xf, axis=-1, keepdims=True) + RMS_EPS)
    return (y * w.astype(jnp.float32)).astype(x.dtype)


def swiglu_ffn(h, w_gu, w_down):
    g, u = jnp.split(h @ w_gu, 2, axis=-1)
    return (jax.nn.silu(g) * u) @ w_down


def split_in_proj(p):
    offs = []
    acc = 0
    for sz in IN_SPLIT_SIZES[:-1]:
        acc += sz
        offs.append(acc)
    return jnp.split(p, offs, axis=-1)


def causal_depthwise_conv(x, w, b):
    y = lax.conv_general_dilated(
        x, w[:, None, :].astype(x.dtype), window_strides=(1,),
        padding=[(CONV_WIDTH - 1, 0)], dimension_numbers=('NWC', 'WIO', 'NWC'),
        feature_group_count=x.shape[-1])
    return y + b.astype(x.dtype)


def ssd_chunked(xh, dt, A, Bm, Cm):
    b, s = xh.shape[:2]
    nc = s // SSM_CHUNK
    r = SSM_HEADS // SSM_GROUPS
    X = (xh * dt[..., None]).reshape(b, nc, SSM_CHUNK, SSM_GROUPS, r, SSM_HEAD_DIM)
    a = (dt * A).reshape(b, nc, SSM_CHUNK, SSM_GROUPS, r)
    Bc = Bm.reshape(b, nc, SSM_CHUNK, SSM_GROUPS, SSM_STATE)
    Cc = Cm.reshape(b, nc, SSM_CHUNK, SSM_GROUPS, SSM_STATE)
    a_cum = jnp.cumsum(a, axis=2)
    seg = a_cum[:, :, :, None] - a_cum[:, :, None, :]
    causal = jnp.tril(jnp.ones((SSM_CHUNK, SSM_CHUNK), dtype=bool))[:, :, None, None]
    Ldec = jnp.exp(jnp.where(causal, seg, -jnp.inf))
    CB = jnp.einsum('bclgn,bcsgn->bclsg', Cc, Bc)
    y_diag = jnp.einsum('bclsg,bclsgr,bcsgrp->bclgrp', CB, Ldec, X)
    decay_to_end = jnp.exp(a_cum[:, :, -1:] - a_cum)
    states = jnp.einsum('bclgn,bclgr,bclgrp->bcgrpn', Bc, decay_to_end, X)
    chunk_decay = jnp.exp(a_cum[:, :, -1])

    def step(h, inp):
        st, dec = inp
        return h * dec[..., None, None] + st, h

    h0 = jnp.zeros((b, SSM_GROUPS, r, SSM_HEAD_DIM, SSM_STATE), dtype=X.dtype)
    _, prev = lax.scan(step, h0, (jnp.moveaxis(states, 1, 0), jnp.moveaxis(chunk_decay, 1, 0)))
    prev = jnp.moveaxis(prev, 0, 1)
    y_off = jnp.einsum('bclgn,bcgrpn,bclgr->bclgrp', Cc, prev, jnp.exp(a_cum))
    return (y_diag + y_off).reshape(b, s, SSM_HEADS, SSM_HEAD_DIM)


def ssd_branch(z, xBC, dt_raw, conv_w, conv_b, dt_bias, A_log, D_skip, norm_w):
    dtype = z.dtype
    b, s = z.shape[:2]
    xBC = jax.nn.silu(causal_depthwise_conv(xBC, conv_w, conv_b))
    xs, Bm, Cm = jnp.split(xBC, [SSM_INNER, SSM_INNER + SSM_GROUPS * SSM_STATE], axis=-1)
    xh = xs.reshape(b, s, SSM_HEADS, SSM_HEAD_DIM).astype(jnp.float32)
    Bm = Bm.reshape(b, s, SSM_GROUPS, SSM_STATE).astype(jnp.float32)
    Cm = Cm.reshape(b, s, SSM_GROUPS, SSM_STATE).astype(jnp.float32)
    dt = jax.nn.softplus(dt_raw.astype(jnp.float32) + dt_bias.astype(jnp.float32))
    A = -jnp.exp(A_log.astype(jnp.float32))
    y = ssd_chunked(xh, dt, A, Bm, Cm)
    y = y + D_skip.astype(jnp.float32)[:, None] * xh
    y = y.reshape(b, s, SSM_INNER) * jax.nn.silu(z.astype(jnp.float32))
    yg = y.reshape(b, s, SSM_GROUPS, SSM_INNER // SSM_GROUPS)
    yg = yg * lax.rsqrt(jnp.mean(yg * yg, axis=-1, keepdims=True) + RMS_EPS)
    y = yg.reshape(b, s, SSM_INNER) * norm_w.astype(jnp.float32)
    return y.astype(dtype)


def chunk_band_attention(q, k, v, rel_bias):
    dtype = q.dtype
    b, s = q.shape[:2]
    nc = s // CHUNK
    pad = LEFT_CHUNKS * CHUNK
    scale = ATTN_HEAD_DIM ** -0.5
    qh = q.reshape(b, s, ATTN_HEADS, ATTN_HEAD_DIM) * jnp.asarray(scale, dtype)
    kp = jnp.pad(k.reshape(b, s, ATTN_HEADS, ATTN_HEAD_DIM), ((0, 0), (pad, 0), (0, 0), (0, 0)))
    vp = jnp.pad(v.reshape(b, s, ATTN_HEADS, ATTN_HEAD_DIM), ((0, 0), (pad, 0), (0, 0), (0, 0)))
    qc = jnp.moveaxis(qh.reshape(b, nc, CHUNK, ATTN_HEADS, ATTN_HEAD_DIM), 1, 0)
    rel = (jnp.arange(CHUNK)[:, None] + pad) - jnp.arange(BAND)[None, :]
    idx = jnp.clip(rel, -MAX_REL_DIST, MAX_REL_DIST) + MAX_REL_DIST
    bias = rel_bias.astype(jnp.float32)[:, idx]
    band_pos = jnp.arange(BAND) - pad

    def one_chunk(args):
        c, q_c = args
        start = c * CHUNK
        k_b = lax.dynamic_slice_in_dim(kp, start, BAND, axis=1)
        v_b = lax.dynamic_slice_in_dim(vp, start, BAND, axis=1)
        sc = jnp.einsum('blhd,bjhd->bhlj', q_c, k_b).astype(jnp.float32) + bias[None]
        valid = (start + band_pos) >= 0
        sc = jnp.where(valid[None, None, None, :], sc, -jnp.inf)
        p = jax.nn.softmax(sc, axis=-1).astype(dtype)
        return jnp.einsum('bhlj,bjhd->blhd', p, v_b)

    out = lax.map(one_chunk, (jnp.arange(nc, dtype=jnp.int32), qc))
    return jnp.moveaxis(out, 0, 1).reshape(b, s, ATTN_INNER)


def setup_inputs(seed: int = 0) -> dict:
    key = jax.random.key(seed)
    ks = jax.random.split(key, 24)
    f32 = jnp.float32
    L = DEPTH

    def nrm(k, shape, fan_in):
        return jax.random.normal(k, shape, f32) * (fan_in ** -0.5)

    def gain(k, shape):
        return 1.0 + 0.02 * jax.random.normal(k, shape, f32)

    dt_init = jnp.exp(jax.random.uniform(ks[10], (L, SSM_HEADS), f32, np.log(1e-3), np.log(1e-1)))
    dt_bias = dt_init + jnp.log(-jnp.expm1(-dt_init))
    return {
        "x": jax.random.normal(ks[0], (BATCH, SEQ, D_MODEL), f32),
        "ffn1_norm_w": gain(ks[1], (L, D_MODEL)),
        "ffn1_w_gu": nrm(ks[2], (L, D_MODEL, 2 * D_FF), D_MODEL),
        "ffn1_w_down": nrm(ks[3], (L, D_FF, D_MODEL), D_FF),
        "mix_norm_w": gain(ks[4], (L, D_MODEL)),
        "w_in": nrm(ks[5], (L, D_MODEL, IN_PROJ_DIM), D_MODEL),
        "conv_w": nrm(ks[6], (L, CONV_WIDTH, CONV_DIM), CONV_WIDTH),
        "conv_b": 0.02 * jax.random.normal(ks[7], (L, CONV_DIM), f32),
        "dt_bias": dt_bias,
        "A_log": jnp.log(jax.random.uniform(ks[8], (L, SSM_HEADS), f32, 1.0, 16.0)),
        "D_skip": 1.0 + 0.1 * jax.random.normal(ks[9], (L, SSM_HEADS), f32),
        "ssm_norm_w": gain(ks[11], (L, SSM_INNER)),
        "rel_bias": 0.1 * jax.random.normal(ks[12], (L, ATTN_HEADS, N_REL), f32),
        "w_branch_ssm": nrm(ks[13], (L, SSM_INNER, D_MODEL), SSM_INNER),
        "w_branch_attn": nrm(ks[14], (L, ATTN_INNER, D_MODEL), ATTN_INNER),
        "w_out": nrm(ks[15], (L, D_MODEL, D_MODEL), D_MODEL),
        "ffn2_norm_w": gain(ks[16], (L, D_MODEL)),
        "ffn2_w_gu": nrm(ks[17], (L, D_MODEL, 2 * D_FF), D_MODEL),
        "ffn2_w_down": nrm(ks[18], (L, D_FF, D_MODEL), D_FF),
        "final_norm_w": gain(ks[19], (D_MODEL,)),
    }


def reference(x, ffn1_norm_w, ffn1_w_gu, ffn1_w_down, mix_norm_w, w_in, conv_w, conv_b,
              dt_bias, A_log, D_skip, ssm_norm_w, rel_bias, w_branch_ssm, w_branch_attn,
              w_out, ffn2_norm_w, ffn2_w_gu, ffn2_w_down, final_norm_w):
    for l in range(DEPTH):
        x = x + FFN_RES_SCALE * swiglu_ffn(rmsnorm(x, ffn1_norm_w[l]), ffn1_w_gu[l], ffn1_w_down[l])
        h = rmsnorm(x, mix_norm_w[l])
        z, xBC, dt_raw, q, k, v, g = split_in_proj(h @ w_in[l])
        y_ssm = ssd_branch(z, xBC, dt_raw, conv_w[l], conv_b[l], dt_bias[l], A_log[l],
                           D_skip[l], ssm_norm_w[l])
        y_attn = chunk_band_attention(q, k, v, rel_bias[l])
        g_ssm, g_attn = jnp.split(jax.nn.sigmoid(g), 2, axis=-1)
        merged = g_ssm * (y_ssm @ w_branch_ssm[l]) + g_attn * (y_attn @ w_branch_attn[l])
        x = x + merged @ w_out[l]
        x = x + FFN_RES_SCALE * swiglu_ffn(rmsnorm(x, ffn2_norm_w[l]), ffn2_w_gu[l], ffn2_w_down[l])
    return rmsnorm(x, final_norm_w)
```

```cpp
#include <hip/hip_runtime.h>
#include <cstdio>
#include <cstdint>
#define MK_N_LAUNCHES 16
#define DBG_ATT 0
#define DBG_SSD 0
#define DBG_CHK 0
constexpr int NB = 4, SEQ = 8192, DM = 1024, NH = 16, HD = 64, FF = 2816, NST = 128, NGRP = 2;
constexpr int TOK = NB * SEQ;
constexpr int XBCW = 1536;
constexpr int NIN1 = 5888;
constexpr int NGATE = 2048;
constexpr int NCHUNK = TOK / 64;
constexpr float RMS_EPS = 1e-6f;
constexpr float LOG2E = 1.4426950408889634f;
constexpr float QSCALE = 0.125f * LOG2E;
namespace pg8 {
#define PG8_LAS __attribute__((address_space(3)))
typedef unsigned short bf16_t;
typedef short bf16x8 __attribute__((ext_vector_type(8)));
typedef float f32x4 __attribute__((ext_vector_type(4)));
typedef unsigned u32x4 __attribute__((ext_vector_type(4)));
constexpr int BM = 256, BK = 64, HALF = 128, HTB = HALF * BK * 2  , STAGE_BYTES = 8 * HTB, NXCD = 8, WGM = 8;

__host__ __device__ __forceinline__ int lds_byte(int r, int c) { const int st = (r >> 4) * 2 + (c >> 5), rr = r & 15, cc = c & 31, ob = rr * 64 + cc * 2; return st * 1024 + (ob ^ (((ob >> 9) & 1) << 5)); }
__host__ __device__ __forceinline__ void stage_rc(int b, int& R, int& C) { const int st = b / 1024, sb = b % 1024, swz = sb ^ (((sb >> 9) & 1) << 5); R = (st >> 1) * 16 + swz / 64; C = (st & 1) * 32 + (swz % 64) / 2; }
__host__ __device__ __forceinline__ int perm32(int rho) { const int n = rho >> 4, i = rho & 15; return 8 * (i >> 2) + 4 * n + (i & 3); }

struct Unit { int pm, pn; };
struct Gemm { const bf16_t* A; const bf16_t* Bt; int M, N, K; };

struct StaticOrder {
    int nM, nN, nwg, G, c;
    __host__ __device__ void init(int M, int N, int G_, int c_) { nM = M / BM; nN = N / BM; nwg = nM * nN; G = G_; c = c_; }
    __host__ __device__ bool next(int i, Unit& u) const {
        const long L = (long)i * G + c; if (L >= nwg) return false;
        int wgid = (int)L; { const int q = nwg / NXCD, r = nwg % NXCD, xcd = wgid % NXCD, off = wgid / NXCD; wgid = (xcd < r ? xcd * (q + 1) : r * (q + 1) + (xcd - r) * q) + off; }
        const int nig = WGM * nN, gid = wgid / nig, fm = gid * WGM, gsz = (nM - fm) < WGM ? (nM - fm) : WGM;
        u.pm = fm + ((wgid % nig) % gsz); u.pn = (wgid % nig) / gsz; return true;
    }
    __device__ __forceinline__ void a_ready(const Unit&) const {}
    __device__ __forceinline__ void done(const Unit&) const {}
};
typedef float f32x2 __attribute__((ext_vector_type(2)));
typedef __bf16 bf16x2v __attribute__((ext_vector_type(2)));
__device__ __forceinline__ unsigned cvt_pk_bf16(float lo, float hi) { f32x2 v = {lo, hi}; bf16x2v b = __builtin_convertvector(v, bf16x2v); return __builtin_bit_cast(unsigned, b); }
__device__ __forceinline__ float sigm(float x) { return __builtin_amdgcn_rcpf(1.0f + __builtin_amdgcn_exp2f(-x * 1.4426950408889634f)); }
__device__ __forceinline__ float silu(float x) { return x * sigm(x); }
__device__ __forceinline__ u32x4 pack8(const f32x4 a, const f32x4 b) { u32x4 w; w.x = cvt_pk_bf16(a[0], a[1]); w.y = cvt_pk_bf16(a[2], a[3]); w.z = cvt_pk_bf16(b[0], b[1]); w.w = cvt_pk_bf16(b[2], b[3]); return w; }
__device__ __forceinline__ float bf_lo(unsigned w) { return __uint_as_float(w << 16); }
__device__ __forceinline__ float bf_hi(unsigned w) { return __uint_as_float(w & 0xffff0000u); }
__device__ __forceinline__ void unpack8(const u32x4 w, f32x4& a, f32x4& b) { a[0] = bf_lo(w.x); a[1] = bf_hi(w.x); a[2] = bf_lo(w.y); a[3] = bf_hi(w.y); b[0] = bf_lo(w.z); b[1] = bf_hi(w.z); b[2] = bf_lo(w.w); b[3] = bf_hi(w.w); }
__device__ __forceinline__ float softplus_f(float x) { return fmaxf(x, 0.f) + log1pf(__expf(-fabsf(x))); }

struct EpiSwiglu {
    static constexpr bool PERM = true, AFTER_DRAIN = false;
    bf16_t* O;
    __device__ __forceinline__ void operator()(const f32x4 (&acc)[2][2][4][2], const Unit& u, int wr, int wc, int fr, int fq) const {
        const int row0 = u.pm * BM + wr * 64 + fr, col0 = u.pn * 128 + wc * 32 + 8 * fq;
#pragma unroll
        for (int ai = 0; ai < 2; ++ai)
#pragma unroll
            for (int m = 0; m < 4; ++m) { bf16_t* rowp = O + (size_t)(row0 + ai * HALF + m * 16) * FF + col0;
                f32x4 v0, v1;
#pragma unroll
                for (int j = 0; j < 4; ++j) { v0[j] = silu(acc[ai][0][m][0][j]) * acc[ai][1][m][0][j]; v1[j] = silu(acc[ai][0][m][1][j]) * acc[ai][1][m][1][j]; }
                *(u32x4*)rowp = pack8(v0, v1); }
    }
};
struct EpiResid {
    static constexpr bool PERM = false, AFTER_DRAIN = false;
    const float* base; float* out; float scale;
    __device__ __forceinline__ void operator()(const f32x4 (&acc)[2][2][4][2], const Unit& u, int wr, int wc, int fr, int fq) const {
        const int row0 = u.pm * BM + wr * 64 + fr, col0 = u.pn * BM + wc * 32 + 4 * fq;
#pragma unroll
        for (int ai = 0; ai < 2; ++ai)
#pragma unroll
            for (int m = 0; m < 4; ++m) { const size_t off = (size_t)(row0 + ai * HALF + m * 16) * DM + col0;
#pragma unroll
                for (int bj = 0; bj < 2; ++bj)
#pragma unroll
                    for (int n = 0; n < 2; ++n) { const size_t o = off + bj * HALF + n * 16; const f32x4 bs = *(const f32x4*)(base + o); *(f32x4*)(out + o) = bs + acc[ai][bj][m][n] * scale; }
                asm volatile("" ::: "memory"); }
    }
};
struct EpiIn1 {
    static constexpr bool PERM = true, AFTER_DRAIN = false;
    bf16_t *Z, *XBC, *Q, *K, *V, *HALO; float* DT; const float* dt_bias;
    __device__ __forceinline__ void operator()(const f32x4 (&acc)[2][2][4][2], const Unit& u, int wr, int wc, int fr, int fq) const {
        const int row0 = u.pm * BM + wr * 64 + fr, pn = u.pn, c8 = wc * 32 + 8 * fq;
        if (pn < 22) {
            bf16_t* base; int ld, colt; float sc = 1.f; bool halo = false;
            if (pn < 4) { base = Z; ld = DM; colt = pn * 256; }
            else if (pn < 10) { base = XBC; ld = XBCW; colt = (pn - 4) * 256; halo = true; }
            else if (pn < 14) { base = Q; ld = DM; colt = (pn - 10) * 256; sc = QSCALE; }
            else if (pn < 18) { base = K; ld = DM; colt = (pn - 14) * 256; }
            else { base = V; ld = DM; colt = (pn - 18) * 256; }
#pragma unroll
            for (int ai = 0; ai < 2; ++ai)
#pragma unroll
                for (int m = 0; m < 4; ++m) { const int row = row0 + ai * HALF + m * 16;
#pragma unroll
                    for (int bj = 0; bj < 2; ++bj) { const u32x4 w = pack8(acc[ai][bj][m][0] * sc, acc[ai][bj][m][1] * sc); const int col = colt + bj * HALF + c8;
                        *(u32x4*)(base + (size_t)row * ld + col) = w;
                        if (halo && (row & 63) >= 61) *(u32x4*)(HALO + (size_t)(((row >> 6) + 1) * 3 + ((row & 63) - 61)) * XBCW + col) = w; } }
        } else {
            if (wc == 0 && fq < 2) {
#pragma unroll
                for (int ai = 0; ai < 2; ++ai)
#pragma unroll
                    for (int m = 0; m < 4; ++m) { const int row = row0 + ai * HALF + m * 16;
#pragma unroll
                        for (int n = 0; n < 2; ++n) { const int i0 = 8 * fq + 4 * n; const f32x4 bv = *(const f32x4*)(dt_bias + i0); f32x4 o;
#pragma unroll
                            for (int j = 0; j < 4; ++j) o[j] = softplus_f(acc[ai][0][m][n][j] + bv[j]);
                            *(f32x4*)(DT + (size_t)row * 16 + i0) = o; } }
            }
        }
    }
};
struct EpiGate {
    static constexpr bool PERM = true, AFTER_DRAIN = false;
    bf16_t* G;
    __device__ __forceinline__ void operator()(const f32x4 (&acc)[2][2][4][2], const Unit& u, int wr, int wc, int fr, int fq) const {
        const int row0 = u.pm * BM + wr * 64 + fr, col0 = u.pn * BM + wc * 32 + 8 * fq;
#pragma unroll
        for (int ai = 0; ai < 2; ++ai)
#pragma unroll
            for (int m = 0; m < 4; ++m) { bf16_t* rowp = G + (size_t)(row0 + ai * HALF + m * 16) * NGATE + col0;
#pragma unroll
                for (int bj = 0; bj < 2; ++bj) { f32x4 v0, v1;
#pragma unroll
                    for (int j = 0; j < 4; ++j) { v0[j] = sigm(acc[ai][bj][m][0][j]); v1[j] = sigm(acc[ai][bj][m][1][j]); }
                    *(u32x4*)(rowp + bj * HALF) = pack8(v0, v1); } }
    }
};
template <bool ADD> struct EpiMerge {
    static constexpr bool PERM = true, AFTER_DRAIN = false;
    const bf16_t* G; const bf16_t* MS; bf16_t* O;
    __device__ __forceinline__ void operator()(const f32x4 (&acc)[2][2][4][2], const Unit& u, int wr, int wc, int fr, int fq) const {
        const int row0 = u.pm * BM + wr * 64 + fr, col0 = u.pn * BM + wc * 32 + 8 * fq;
#pragma unroll
        for (int ai = 0; ai < 2; ++ai)
#pragma unroll
            for (int m = 0; m < 4; ++m) { const size_t row = (size_t)(row0 + ai * HALF + m * 16);
#pragma unroll
                for (int bj = 0; bj < 2; ++bj) { const int col = col0 + bj * HALF;
                    f32x4 g0, g1; unpack8(*(const u32x4*)(G + row * NGATE + col), g0, g1);
                    f32x4 v0 = acc[ai][bj][m][0] * g0, v1 = acc[ai][bj][m][1] * g1;
                    if (ADD) { f32x4 m0, m1; unpack8(*(const u32x4*)(MS + row * DM + col), m0, m1); v0 += m0; v1 += m1; }
                    *(u32x4*)(O + row * DM + col) = pack8(v0, v1); } }
    }
};

template <class Epi, class Sched, bool ALIGN_EPI = false, bool SP2 = false>
__device__ __forceinline__ void gemm_phase(PG8_LAS unsigned char* lds, const Gemm g, const Sched& S, const Epi& E) {
    const int tid = threadIdx.x, wid = __builtin_amdgcn_readfirstlane(tid >> 6), lane = tid & 63, wr = wid >> 2, wc = wid & 3, fr = lane & 15, fq = lane >> 4;
    const int K = g.K, nt = K / BK;
    unsigned voffA[2], voffB[2];
#pragma unroll
    for (int i = 0; i < 2; ++i) { int R, C; stage_rc(tid * 16 + i * 8192, R, C); const int Rb = Epi::PERM ? ((R & ~31) + perm32(R & 31)) : R;
        voffA[i] = (unsigned)(R * K + C) * 2u; voffB[i] = (unsigned)(Rb * K + C) * 2u; }
    const size_t kstep = (size_t)(BK * 2);
    const size_t hstep = (size_t)HALF * K * 2;
    const size_t tstep = 2 * hstep;
    const unsigned ldsw = (unsigned)wid * 1024u;
    const int aoff = lds_byte(wr * 64 + fr, fq * 8), boff = lds_byte(wc * 32 + fr, fq * 8);
#define PG8_SA(b, h) (((b) * 2 + (h)) * HTB)
#define PG8_SB(b, h) ((4 + (b) * 2 + (h)) * HTB)
#define PG8_STAGE(bufoff, gbase, voff) do { _Pragma("unroll") for (int _i = 0; _i < 2; ++_i) \
        __builtin_amdgcn_global_load_lds((const unsigned*)((const char*)(gbase) + (voff)[_i]), (PG8_LAS unsigned*)(lds + (bufoff) + ldsw + _i * 8192), 16, 0, 0); } while (0)
#define PG8_LDA(dst, b, h) do { _Pragma("unroll") for (int m = 0; m < 4; ++m) _Pragma("unroll") for (int k = 0; k < 2; ++k) dst[m][k] = *(const PG8_LAS bf16x8*)(lds + PG8_SA(b, h) + aoff + m * 2048 + k * 1024); } while (0)
#define PG8_LDB(dst, b, h) do { _Pragma("unroll") for (int n = 0; n < 2; ++n) _Pragma("unroll") for (int k = 0; k < 2; ++k) dst[n][k] = *(const PG8_LAS bf16x8*)(lds + PG8_SB(b, h) + boff + n * 2048 + k * 1024); } while (0)
#define PG8_MMA(ai, bj, At, Bt) do { __builtin_amdgcn_s_setprio(1); _Pragma("unroll") for (int m = 0; m < 4; ++m) _Pragma("unroll") for (int n = 0; n < 2; ++n) _Pragma("unroll") for (int k = 0; k < 2; ++k) \
        acc[ai][bj][m][n] = __builtin_amdgcn_mfma_f32_16x16x32_bf16(Bt[n][k], At[m][k], acc[ai][bj][m][n], 0, 0, 0); __builtin_amdgcn_s_setprio(0); } while (0)
#define PG8_WAIT_V(n) asm volatile("s_waitcnt vmcnt(" #n ")" ::: "memory")
#define PG8_WAIT_L(n) asm volatile("s_waitcnt lgkmcnt(" #n ")" ::: "memory")
#define PG8_BAR __builtin_amdgcn_s_barrier()
#define PG8_SCHED __builtin_amdgcn_sched_barrier(0)
    Unit cur, nxt; int ui = 0;
    if (!S.next(0, cur)) return;
    f32x4 acc[2][2][4][2];
#pragma unroll
    for (int a = 0; a < 2; ++a)
#pragma unroll
        for (int b = 0; b < 2; ++b)
#pragma unroll
            for (int m = 0; m < 4; ++m)
#pragma unroll
                for (int n = 0; n < 2; ++n) acc[a][b][m][n] = (f32x4){0.f, 0.f, 0.f, 0.f};
    bf16x8 At[4][2], B0[2][2], B1[2][2];
    const char* cA = (const char*)g.A + (size_t)cur.pm * tstep; const char* cB = (const char*)g.Bt + (size_t)cur.pn * tstep;
    S.a_ready(cur);
    if constexpr (SP2) {
        PG8_STAGE(PG8_SB(0, 0), cB, voffB); PG8_STAGE(PG8_SB(0, 1), cB + hstep, voffB); PG8_STAGE(PG8_SA(0, 0), cA, voffA); PG8_STAGE(PG8_SA(0, 1), cA + hstep, voffA);
        if (wr == 1) PG8_BAR;
        PG8_WAIT_V(2); PG8_BAR;
        PG8_STAGE(PG8_SB(1, 0), cB + kstep, voffB); PG8_STAGE(PG8_SA(1, 0), cA + kstep, voffA); PG8_STAGE(PG8_SB(1, 1), cB + hstep + kstep, voffB);
        PG8_WAIT_V(6); PG8_BAR;
    } else {
        PG8_STAGE(PG8_SB(0, 0), cB, voffB); PG8_STAGE(PG8_SA(0, 0), cA, voffA); PG8_STAGE(PG8_SB(0, 1), cB + hstep, voffB); PG8_STAGE(PG8_SA(0, 1), cA + hstep, voffA);
        if (wr == 1) PG8_BAR;
        PG8_WAIT_V(4); PG8_BAR;
        PG8_STAGE(PG8_SB(1, 0), cB + kstep, voffB); PG8_STAGE(PG8_SA(1, 0), cA + kstep, voffA); PG8_STAGE(PG8_SB(1, 1), cB + hstep + kstep, voffB);
        PG8_WAIT_V(6); PG8_BAR;
    }
    for (;;) {
        const bool has_next = S.next(ui + 1, nxt);
        const char* nA = has_next ? (const char*)g.A + (size_t)nxt.pm * tstep : cA; const char* nB = has_next ? (const char*)g.Bt + (size_t)nxt.pn * tstep : cB;
        for (int t = 0; t < nt; t += 2) {
            const bool last = (t == nt - 2);
            const char* a1 = cA + (size_t)(t + 1) * kstep;
            const char* a2 = last ? nA : cA + (size_t)(t + 2) * kstep; const char* b2 = last ? nB : cB + (size_t)(t + 2) * kstep;
            const char* a3 = a2 + kstep; const char* b3 = b2 + kstep;
            if (last && has_next) S.a_ready(nxt);
            if constexpr (SP2) {
            PG8_LDB(B0, 0, 0); PG8_LDB(B1, 0, 1); PG8_SCHED; PG8_LDA(At, 0, 0); PG8_STAGE(PG8_SA(1, 1), a1 + hstep, voffA);
            PG8_WAIT_V(8); PG8_WAIT_L(0); PG8_BAR; PG8_MMA(0, 0, At, B0); PG8_MMA(0, 1, At, B1); PG8_BAR; PG8_SCHED;
            PG8_LDA(At, 0, 1); PG8_STAGE(PG8_SB(0, 0), b2, voffB); PG8_STAGE(PG8_SB(0, 1), b2 + hstep, voffB); PG8_STAGE(PG8_SA(0, 0), a2, voffA);
            PG8_WAIT_V(8); PG8_WAIT_L(0); PG8_BAR; PG8_MMA(1, 0, At, B0); PG8_MMA(1, 1, At, B1); PG8_BAR; PG8_SCHED;
            PG8_LDB(B0, 1, 0); PG8_LDB(B1, 1, 1); PG8_SCHED; PG8_LDA(At, 1, 0); PG8_STAGE(PG8_SA(0, 1), a2 + hstep, voffA);
            PG8_WAIT_V(8); PG8_WAIT_L(0); PG8_BAR; PG8_MMA(0, 0, At, B0); PG8_MMA(0, 1, At, B1); PG8_BAR; PG8_SCHED;
            PG8_LDA(At, 1, 1); PG8_STAGE(PG8_SB(1, 0), b3, voffB); PG8_STAGE(PG8_SB(1, 1), b3 + hstep, voffB); PG8_STAGE(PG8_SA(1, 0), a3, voffA);
            PG8_WAIT_V(8); PG8_WAIT_L(0); PG8_BAR; PG8_MMA(1, 0, At, B0); PG8_MMA(1, 1, At, B1); PG8_BAR; PG8_SCHED;
            } else {
            PG8_LDB(B0, 0, 0); PG8_SCHED; PG8_LDA(At, 0, 0); PG8_STAGE(PG8_SA(1, 1), a1 + hstep, voffA);
            PG8_WAIT_L(8); PG8_BAR; PG8_WAIT_L(0); PG8_MMA(0, 0, At, B0); PG8_BAR; PG8_SCHED;
            PG8_LDB(B1, 0, 1); PG8_STAGE(PG8_SB(0, 0), b2, voffB);
            PG8_BAR; PG8_WAIT_L(0); PG8_MMA(0, 1, At, B1); PG8_BAR;
            PG8_LDA(At, 0, 1); PG8_STAGE(PG8_SA(0, 0), a2, voffA);
            PG8_BAR; PG8_WAIT_L(0); PG8_MMA(1, 0, At, B0); PG8_BAR; PG8_SCHED;
            PG8_STAGE(PG8_SB(0, 1), b2 + hstep, voffB);
            PG8_WAIT_V(6); PG8_BAR; PG8_MMA(1, 1, At, B1); PG8_BAR;
            PG8_LDB(B0, 1, 0); PG8_SCHED; PG8_LDA(At, 1, 0); PG8_STAGE(PG8_SA(0, 1), a2 + hstep, voffA);
            PG8_WAIT_L(8); PG8_BAR; PG8_WAIT_L(0); PG8_MMA(0, 0, At, B0); PG8_BAR; PG8_SCHED;
            PG8_LDB(B1, 1, 1); PG8_STAGE(PG8_SB(1, 0), b3, voffB);
            PG8_BAR; PG8_WAIT_L(0); PG8_MMA(0, 1, At, B1); PG8_BAR;
            PG8_LDA(At, 1, 1); PG8_STAGE(PG8_SA(1, 0), a3, voffA);
            PG8_BAR; PG8_WAIT_L(0); PG8_MMA(1, 0, At, B0); PG8_BAR; PG8_SCHED;
            PG8_STAGE(PG8_SB(1, 1), b3 + hstep, voffB);
            PG8_WAIT_V(6); PG8_BAR; PG8_MMA(1, 1, At, B1); PG8_BAR;
            }
        }
        if constexpr (ALIGN_EPI) { if (wr == 0) PG8_BAR; }
        if constexpr (!Epi::AFTER_DRAIN) { E(acc, cur, wr, wc, fr, fq); S.done(cur); }
        if (!has_next) break;
#pragma unroll
        for (int a = 0; a < 2; ++a)
#pragma unroll
            for (int b = 0; b < 2; ++b)
#pragma unroll
                for (int m = 0; m < 4; ++m)
#pragma unroll
                    for (int n = 0; n < 2; ++n) acc[a][b][m][n] = (f32x4){0.f, 0.f, 0.f, 0.f};
        cur = nxt; cA = nA; cB = nB; ++ui;
        if constexpr (ALIGN_EPI) { if (wr == 1) PG8_BAR; }
    }
    PG8_WAIT_V(0);
    if constexpr (!ALIGN_EPI) { if (wr == 0) PG8_BAR; }
    PG8_BAR;
    if constexpr (Epi::AFTER_DRAIN) { E.fused(acc, cur, wr, wc, fr, fq, lds, wid, lane); S.done(cur); }
#undef PG8_SA
#undef PG8_SB
#undef PG8_STAGE
#undef PG8_LDA
#undef PG8_LDB
#undef PG8_MMA
#undef PG8_WAIT_V
#undef PG8_WAIT_L
#undef PG8_BAR
#undef PG8_SCHED
}
}
constexpr int NWAVES = 8;
#ifndef MK_N_LAUNCHES
#define MK_N_LAUNCHES 1
#endif
constexpr int N_PHASES = 16;
constexpr int N_LAUNCHES = MK_N_LAUNCHES;

constexpr size_t MiB = 1u << 20;
constexpr size_t WS_CTL = 0, CTL_ZERO_BYTES = 1 * MiB;
constexpr size_t WS_WGU1 = 1 * MiB;
constexpr size_t WS_WD1  = 12 * MiB;
constexpr size_t WS_WIN  = 18 * MiB;
constexpr size_t WS_WBS  = 34 * MiB, WS_WBA = 36 * MiB, WS_WOUT = 38 * MiB;
constexpr size_t WS_WGU2 = 40 * MiB, WS_WD2 = 51 * MiB;
constexpr size_t WS_XN   = 57 * MiB;
constexpr size_t WS_Z    = 121 * MiB;
constexpr size_t WS_XBC  = 185 * MiB;
constexpr size_t WS_Q    = 281 * MiB;
constexpr size_t WS_K    = 345 * MiB, WS_V = 409 * MiB;
constexpr size_t WS_DT   = 473 * MiB;
constexpr size_t WS_HALO = 475 * MiB;
constexpr size_t WS_ACT  = 121 * MiB;
constexpr size_t WS_ST   = 345 * MiB;
constexpr size_t WS_G    = 345 * MiB;
constexpr size_t WS_MS   = 185 * MiB;
constexpr size_t WS_END  = 480 * MiB;
constexpr int CW_BAR = 4096;

constexpr int RING_OFF = 0, RING_BYTES = 131072;
constexpr int LDSCTL_OFF = RING_BYTES, MISC_OFF = LDSCTL_OFF + 320;
constexpr int LDS_BYTES = 147456;

#define GAS __attribute__((address_space(1)))
#define LAS __attribute__((address_space(3)))
typedef unsigned short bf16;
typedef unsigned v4u __attribute__((ext_vector_type(4)));
typedef float f32x4 __attribute__((ext_vector_type(4)));
typedef short bf16x8 __attribute__((ext_vector_type(8)));
typedef GAS unsigned gu32;
typedef GAS unsigned long long gu64;
#define RLX_AGENT __ATOMIC_RELAXED, __HIP_MEMORY_SCOPE_AGENT
#define LDS_WAIT() asm volatile("s_waitcnt lgkmcnt(0)" ::: "memory")
#define VM_WAIT() asm volatile("s_waitcnt vmcnt(0)" ::: "memory")
__device__ __forceinline__ unsigned long long rt() { return __builtin_amdgcn_s_memrealtime(); }
__device__ __forceinline__ unsigned f2bf(float f) { unsigned u = __builtin_bit_cast(unsigned, f); return (u + 0x7fffu + ((u >> 16) & 1u)) >> 16; }
__device__ __forceinline__ unsigned pk2(float lo, float hi) { return f2bf(lo) | (f2bf(hi) << 16); }
#define XB_TMO      128
#define XB_XCNT(j)  (256  + 64 * (j))
#define XB_XSUB(j)  (1280 + 64 * (j))
#define XB_XGEN(j)  (2304 + 64 * (j))
#define XB_TOP      3328
#define XB_TOPGEN   3392
#define XCD_BAR_WORDS 3456
#define XB_SPIN_CAP (1u << 22)

__device__ __forceinline__ unsigned xb_ld(unsigned* p)              { return __hip_atomic_load(p, __ATOMIC_RELAXED, __HIP_MEMORY_SCOPE_AGENT); }
__device__ __forceinline__ unsigned xb_add(unsigned* p, unsigned v) { return __hip_atomic_fetch_add(p, v, __ATOMIC_RELAXED, __HIP_MEMORY_SCOPE_AGENT); }
__device__ __forceinline__ unsigned xb_xcc_id() { return (unsigned)__builtin_amdgcn_s_getreg((3 << 11) | 20) & 0xFu; }
#define XB_SPIN(cond, bar) do { unsigned _sp = 0; while (cond) { __builtin_amdgcn_s_sleep(1); \
    if ((++_sp & 255u) == 0u) { if (xb_ld(&(bar)[XB_TMO])) break; if (_sp > XB_SPIN_CAP) { atomicAdd(&(bar)[XB_TMO], 1u); break; } } } } while (0)

struct XcdBarrier {
    unsigned* bar; unsigned x;
    volatile LAS unsigned* st;
};

__device__ __forceinline__ XcdBarrier xcd_barrier_post(unsigned* bar, volatile LAS unsigned* st) {
    XcdBarrier b; b.bar = bar; b.x = xb_xcc_id(); b.st = st;
    if (threadIdx.x == 0) (void)xb_add(&bar[XB_XCNT(b.x)], 1u);
    return b;
}
__device__ __forceinline__ void xcd_barrier_complete(unsigned* bar, unsigned x, unsigned& nloc, unsigned& nx) {
    const unsigned G = gridDim.x * gridDim.y * gridDim.z;
    unsigned sum, cnt, mine, sp = 0u;
    for (;;) {
        sum = 0u; cnt = 0u; mine = 0u;
#pragma unroll
        for (unsigned j = 0; j < 16; ++j) { const unsigned c = xb_ld(&bar[XB_XCNT(j)]); sum += c; cnt += (c > 0u) ? 1u : 0u; mine = (j == x) ? c : mine; }
        if (sum == G) break;
        __builtin_amdgcn_s_sleep(1);
        if ((++sp & 255u) == 0u) { if (xb_ld(&bar[XB_TMO])) break; if (sp > XB_SPIN_CAP) { atomicAdd(&bar[XB_TMO], 1u); break; } }
    }
    nloc = mine > 0u ? mine : 1u; nx = cnt > 0u ? cnt : 1u;
}

__device__ __forceinline__ void xcd_barrier(const XcdBarrier& b) {
    asm volatile("s_waitcnt vmcnt(0)" ::: "memory");
    __syncthreads();
    if (threadIdx.x == 0) {
        unsigned* bar = b.bar;
        __builtin_amdgcn_s_waitcnt(0);
        unsigned nloc = b.st[0], nx = b.st[1];
        if (nloc == 0u) { xcd_barrier_complete(bar, b.x, nloc, nx); b.st[0] = nloc; b.st[1] = nx; }
        const unsigned old = xb_add(&bar[XB_XSUB(b.x)], 1u);
        const unsigned gen = old / nloc;
        if (old + 1u == (gen + 1u) * nloc) {
            __builtin_amdgcn_fence(__ATOMIC_RELEASE, "agent");
            asm volatile("s_waitcnt vmcnt(0)" ::: "memory");
            const unsigned og = xb_add(&bar[XB_TOP], 1u);
            const unsigned tg = og / nx;
            if (og + 1u == (tg + 1u) * nx) xb_add(&bar[XB_TOPGEN], 1u);
            else XB_SPIN(xb_ld(&bar[XB_TOPGEN]) == tg, bar);
            __builtin_amdgcn_fence(__ATOMIC_ACQUIRE, "agent");
            xb_add(&bar[XB_XGEN(b.x)], 1u);
            asm volatile("s_waitcnt vmcnt(0)" ::: "memory");
        } else {
            XB_SPIN(xb_ld(&bar[XB_XGEN(b.x)]) == gen, bar);
            __builtin_amdgcn_fence(__ATOMIC_ACQUIRE, "agent");
            asm volatile("s_waitcnt vmcnt(0)" ::: "memory");
        }
    }
    __syncthreads();
}

struct Frame {
    LAS unsigned char* lds;
    volatile LAS unsigned* MISC;
    gu32* ctl;
    int tid, lane, wave;
    int vcu, G;
};
typedef unsigned u32x2v __attribute__((ext_vector_type(2)));
typedef short s16x4 __attribute__((ext_vector_type(4)));
typedef float f32x16 __attribute__((ext_vector_type(16)));
typedef float f32x2_t __attribute__((ext_vector_type(2)));
typedef __bf16 bf16x2_t __attribute__((ext_vector_type(2)));
__device__ __forceinline__ unsigned cvtpk_s(float lo, float hi) { f32x2_t v = {lo, hi}; bf16x2_t b = __builtin_convertvector(v, bf16x2_t); return __builtin_bit_cast(unsigned, b); }
__device__ __forceinline__ float bflo(unsigned w) { return __uint_as_float(w << 16); }
__device__ __forceinline__ float bfhi(unsigned w) { return __uint_as_float(w & 0xffff0000u); }
__device__ __forceinline__ float sigm_f(float x) { return __builtin_amdgcn_rcpf(1.0f + __builtin_amdgcn_exp2f(-x * LOG2E)); }
__device__ __forceinline__ float silu_f(float x) { return x * sigm_f(x); }
#define MFMA16(a, b, c) __builtin_amdgcn_mfma_f32_16x16x32_bf16((a), (b), (c), 0, 0, 0)
#define MFMA32(a, b, c) __builtin_amdgcn_mfma_f32_32x32x16_bf16((a), (b), (c), 0, 0, 0)

__device__ __forceinline__ float wave_sum(float v) {
#pragma unroll
    for (int o = 1; o < 64; o <<= 1) v += __shfl_xor(v, o);
    return v;
}
template <int MODE> __device__ __forceinline__ int src_col(int R) {
    if (MODE == 0) return R;
    if (MODE == 1) { const int pn = R >> 8, w = R & 255; return (w >> 7) * FF + 128 * pn + (w & 127); }
    if (R < 2560) return R;
    if (R < 5632) return R + 16;
    if (R < 5648) return 2560 + (R - 5632);
    if (R < 5888) return -1;
    return 5648 + (R - 5888);
}
template <int MODE> __device__ __forceinline__ void p0_item(const float* W, int K, int Nsrc, bf16* WT, int nblk, LAS float* scr, int item, int lane) {
    const int kb = item / nblk, nb = item - kb * nblk, k0 = 64 * kb, n0 = 32 * nb;
    const int sc = src_col<MODE>(n0 + (lane & 31));
#pragma unroll 8
    for (int i = 0; i < 32; ++i) { const int kk = 2 * i + (lane >> 5); scr[kk * 33 + (lane & 31)] = (sc >= 0) ? W[(size_t)(k0 + kk) * Nsrc + sc] : 0.f; }
    LDS_WAIT(); asm volatile("" ::: "memory");
    const int c = lane & 7;
#pragma unroll
    for (int j = 0; j < 4; ++j) { const int n = (lane >> 3) + 8 * j; const LAS float* s = scr + (8 * c) * 33 + n;
        v4u o; o.x = pk2(s[0 * 33], s[1 * 33]); o.y = pk2(s[2 * 33], s[3 * 33]); o.z = pk2(s[4 * 33], s[5 * 33]); o.w = pk2(s[6 * 33], s[7 * 33]);
        *(GAS v4u*)(WT + (size_t)(n0 + n) * K + k0 + 8 * c) = o; }
    LDS_WAIT(); asm volatile("" ::: "memory");
}
__device__ __forceinline__ void rms_row_to_bf16(int lane, const float* xrow, const float* w, bf16* orow) {
    const GAS f32x4* xr = (const GAS f32x4*)xrow + lane; const GAS f32x4* wr = (const GAS f32x4*)w + lane;
    f32x4 v[4]; float s = 0.f;
#pragma unroll
    for (int j = 0; j < 4; ++j) { v[j] = xr[64 * j]; s += (v[j].x * v[j].x + v[j].y * v[j].y) + (v[j].z * v[j].z + v[j].w * v[j].w); }
    const float rs = 1.0f / sqrtf(wave_sum(s) * (1.f / DM) + RMS_EPS);
    GAS unsigned long long* o8 = (GAS unsigned long long*)orow + lane;
#pragma unroll
    for (int j = 0; j < 4; ++j) { const f32x4 wv = wr[64 * j];
        o8[64 * j] = (unsigned long long)pk2(v[j].x * rs * wv.x, v[j].y * rs * wv.y) | ((unsigned long long)pk2(v[j].z * rs * wv.z, v[j].w * rs * wv.w) << 32); }
}
__device__ __forceinline__ void rms_row_f32_inplace(int lane, float* xrow, const float* w) {
    GAS f32x4* xr = (GAS f32x4*)xrow + lane; const GAS f32x4* wr = (const GAS f32x4*)w + lane;
    f32x4 v[4]; float s = 0.f;
#pragma unroll
    for (int j = 0; j < 4; ++j) { v[j] = xr[64 * j]; s += (v[j].x * v[j].x + v[j].y * v[j].y) + (v[j].z * v[j].z + v[j].w * v[j].w); }
    const float rs = 1.0f / sqrtf(wave_sum(s) * (1.f / DM) + RMS_EPS);
#pragma unroll
    for (int j = 0; j < 4; ++j) { const f32x4 wv = wr[64 * j]; xr[64 * j] = (v[j] * rs) * wv; }
}
__device__ __forceinline__ void norm_pass(Frame& F, const float* src, const float* w, bf16* dst) {
    const int gw = F.vcu * NWAVES + F.wave, NGW = F.G * NWAVES;
    for (int m = gw; m < TOK; m += NGW) rms_row_to_bf16(F.lane, src + (size_t)m * DM, w, dst + (size_t)m * DM);
}
struct P0Args { const float *x, *nw, *wgu1, *wd1, *win, *wbs, *wba, *wout, *wgu2, *wd2; bf16 *Wgu1, *Wd1, *Win, *Wbs, *Wba, *Wout, *Wgu2, *Wd2, *XN; };
__device__ __forceinline__ void p0_prologue(Frame& F, const P0Args& a) {
    LAS float* scr = (LAS float*)(F.lds + RING_OFF + F.wave * 16384);
    const int gw = F.vcu * NWAVES + F.wave, NGW = F.G * NWAVES;
    constexpr int I_GU = (DM / 64) * (2 * FF / 32), I_D = (FF / 64) * (DM / 32), I_IN = (DM / 64) * (7936 / 32), I_SQ = (DM / 64) * (DM / 32);
    constexpr int NITEMS = 2 * I_GU + 2 * I_D + I_IN + 3 * I_SQ;
    for (int it = gw; it < NITEMS; it += NGW) {
        int r = it;
        if (r < I_GU) { p0_item<1>(a.wgu1, DM, 2 * FF, a.Wgu1, 2 * FF / 32, scr, r, F.lane); continue; } r -= I_GU;
        if (r < I_GU) { p0_item<1>(a.wgu2, DM, 2 * FF, a.Wgu2, 2 * FF / 32, scr, r, F.lane); continue; } r -= I_GU;
        if (r < I_D) { p0_item<0>(a.wd1, FF, DM, a.Wd1, DM / 32, scr, r, F.lane); continue; } r -= I_D;
        if (r < I_D) { p0_item<0>(a.wd2, FF, DM, a.Wd2, DM / 32, scr, r, F.lane); continue; } r -= I_D;
        if (r < I_IN) { p0_item<2>(a.win, DM, 7696, a.Win, 7936 / 32, scr, r, F.lane); continue; } r -= I_IN;
        if (r < I_SQ) { p0_item<0>(a.wbs, DM, DM, a.Wbs, DM / 32, scr, r, F.lane); continue; } r -= I_SQ;
        if (r < I_SQ) { p0_item<0>(a.wba, DM, DM, a.Wba, DM / 32, scr, r, F.lane); continue; } r -= I_SQ;
        p0_item<0>(a.wout, DM, DM, a.Wout, DM / 32, scr, r, F.lane);
    }
    norm_pass(F, a.x, a.nw, a.XN);
}
__device__ __forceinline__ void conv_pass(Frame& F, bf16* XBC, const bf16* HALO, const float* conv_w, const float* conv_b) {
    constexpr int NIT = NCHUNK * 192;
    for (int item = F.vcu * 512 + F.tid; item < NIT; item += F.G * 512) {
        const int chunk = item / 192, ch0 = (item - chunk * 192) * 8;
        float w0[8], w1[8], w2[8], w3[8], bb[8], r0[8], r1[8], r2[8];
#pragma unroll
        for (int e = 0; e < 8; ++e) { w0[e] = conv_w[0 * XBCW + ch0 + e]; w1[e] = conv_w[1 * XBCW + ch0 + e]; w2[e] = conv_w[2 * XBCW + ch0 + e]; w3[e] = conv_w[3 * XBCW + ch0 + e]; bb[e] = conv_b[ch0 + e]; }
        if ((chunk & 127) == 0) {
#pragma unroll
            for (int e = 0; e < 8; ++e) { r0[e] = 0.f; r1[e] = 0.f; r2[e] = 0.f; }
        } else {
            const v4u h0 = *(const GAS v4u*)(HALO + (size_t)(chunk * 3 + 0) * XBCW + ch0), h1 = *(const GAS v4u*)(HALO + (size_t)(chunk * 3 + 1) * XBCW + ch0), h2 = *(const GAS v4u*)(HALO + (size_t)(chunk * 3 + 2) * XBCW + ch0);
            r0[0] = bflo(h0.x); r0[1] = bfhi(h0.x); r0[2] = bflo(h0.y); r0[3] = bfhi(h0.y); r0[4] = bflo(h0.z); r0[5] = bfhi(h0.z); r0[6] = bflo(h0.w); r0[7] = bfhi(h0.w);
            r1[0] = bflo(h1.x); r1[1] = bfhi(h1.x); r1[2] = bflo(h1.y); r1[3] = bfhi(h1.y); r1[4] = bflo(h1.z); r1[5] = bfhi(h1.z); r1[6] = bflo(h1.w); r1[7] = bfhi(h1.w);
            r2[0] = bflo(h2.x); r2[1] = bfhi(h2.x); r2[2] = bflo(h2.y); r2[3] = bfhi(h2.y); r2[4] = bflo(h2.z); r2[5] = bfhi(h2.z); r2[6] = bflo(h2.w); r2[7] = bfhi(h2.w);
        }
        bf16* p = XBC + (size_t)chunk * 64 * XBCW + ch0;
#pragma unroll 4
        for (int t = 0; t < 64; ++t) {
            const v4u raw = *(const GAS v4u*)(p + (size_t)t * XBCW);
            float cur[8]; cur[0] = bflo(raw.x); cur[1] = bfhi(raw.x); cur[2] = bflo(raw.y); cur[3] = bfhi(raw.y); cur[4] = bflo(raw.z); cur[5] = bfhi(raw.z); cur[6] = bflo(raw.w); cur[7] = bfhi(raw.w);
            float y[8];
#pragma unroll
            for (int e = 0; e < 8; ++e) { y[e] = silu_f(bb[e] + w0[e] * r0[e] + w1[e] * r1[e] + w2[e] * r2[e] + w3[e] * cur[e]); r0[e] = r1[e]; r1[e] = r2[e]; r2[e] = cur[e]; }
            v4u o; o.x = cvtpk_s(y[0], y[1]); o.y = cvtpk_s(y[2], y[3]); o.z = cvtpk_s(y[4], y[5]); o.w = cvtpk_s(y[6], y[7]);
            *(GAS v4u*)(p + (size_t)t * XBCW) = o;
        }
    }
}
namespace att {
constexpr int K_OFF = 0, V_OFF = 16384, TBL_OFF = 32768, WSF_OFF = 32768 + 2048;
__device__ __forceinline__ int crow(int r, int hi) { return (r & 3) + 8 * (r >> 2) + 4 * hi; }
typedef short v4i16_t __attribute__((ext_vector_type(4)));
__device__ __forceinline__ s16x4 vtr(const LAS unsigned char* p) { return __builtin_bit_cast(s16x4, __builtin_amdgcn_ds_read_tr16_b64_v4i16((LAS v4i16_t*)p)); }
__device__ __forceinline__ void attn_unit(LAS unsigned char* lds, const bf16* Q, const bf16* K, const bf16* V, bf16* O, const float* rel_bias, int b, int h, int qblk) {
    const int tid = threadIdx.x, lane = tid & 63, r32 = lane & 31, hi = lane >> 5; const int wid = __builtin_amdgcn_readfirstlane(tid >> 6);
    const int wq = wid >> 1, c0 = qblk * 4, cq = c0 + wq;
    const int qo = 32 * (wid & 1) + r32;
    const size_t rowq = (size_t)b * SEQ + (size_t)64 * cq + 32 * (wid & 1);
    LAS float* tbl = (LAS float*)(lds + TBL_OFF);
    LAS float* wsf = (LAS float*)(lds + WSF_OFF) + wid * 64;
    for (int i = tid; i < 257; i += 512) tbl[i] = rel_bias[h * 257 + i] * LOG2E;
    bf16x8 qr[4];
    { const bf16* Qw = Q + (rowq + r32) * DM + h * HD;
#pragma unroll
      for (int d0 = 0; d0 < 4; ++d0) qr[d0] = *(const GAS bf16x8*)(Qw + d0 * 16 + hi * 8); }
    float mrun = -INFINITY, lrun = 0.f; f32x16 o0, o1;
#pragma unroll
    for (int r = 0; r < 16; ++r) { o0[r] = 0.f; o1[r] = 0.f; }
    for (int t = 0; t < 12; ++t) {
        const int ck = c0 - 8 + t; if (ck < 0) continue;
        const size_t krow = (size_t)b * SEQ + (size_t)ck * 64;
        const v4u kv = *(const GAS v4u*)(K + (krow + lane) * DM + h * HD + wid * 8);
        const v4u vv = *(const GAS v4u*)(V + (krow + 16 * (wid & 3) + (lane >> 2)) * DM + h * HD + (wid >> 2) * 32 + (lane & 3) * 8);
        const int buf = (t & 1) * 8192;
        *(LAS v4u*)(lds + K_OFF + buf + wid * 1024 + lane * 16) = kv;
        *(LAS v4u*)(lds + V_OFF + buf + wid * 1024 + lane * 16) = vv;
        __syncthreads();
        const int jd = wq + 8 - t;
        if (jd >= 0 && jd <= 8) {
            const LAS unsigned char* kb = lds + K_OFF + buf + hi * 1024 + r32 * 16;
            f32x16 p0, p1;
#pragma unroll
            for (int r = 0; r < 16; ++r) { p0[r] = 0.f; p1[r] = 0.f; }
#pragma unroll
            for (int d0 = 0; d0 < 4; ++d0) {
                const bf16x8 b0 = *(const LAS bf16x8*)(kb + d0 * 2048), b1 = *(const LAS bf16x8*)(kb + d0 * 2048 + 512);
                p0 = MFMA32(b0, qr[d0], p0); p1 = MFMA32(b1, qr[d0], p1); }
            if (jd >= 3) { const float cb = tbl[256];
#pragma unroll
                for (int r = 0; r < 16; ++r) { p0[r] += cb; p1[r] += cb; }
            } else { const int base = 64 * jd + qo + 128;
#pragma unroll
                for (int r = 0; r < 16; ++r) { const int i0 = base - crow(r, hi), i1 = i0 - 32; p0[r] += tbl[i0 < 256 ? i0 : 256]; p1[r] += tbl[i1 < 256 ? i1 : 256]; }
            }
            float mx = fmaxf(p0[0], p1[0]);
#pragma unroll
            for (int r = 1; r < 16; ++r) mx = fmaxf(mx, fmaxf(p0[r], p1[r]));
            mx = fmaxf(mx, __shfl_xor(mx, 32));
            const float mnew = fmaxf(mrun, mx);
            const float alpha = __builtin_amdgcn_exp2f(mrun - mnew);
            mrun = mnew;
            float ls = 0.f;
#pragma unroll
            for (int r = 0; r < 16; ++r) { p0[r] = __builtin_amdgcn_exp2f(p0[r] - mnew); p1[r] = __builtin_amdgcn_exp2f(p1[r] - mnew); ls += p0[r] + p1[r]; }
            lrun = lrun * alpha + ls;
            if (hi == 0) wsf[r32] = alpha;
            asm volatile("s_waitcnt lgkmcnt(0)" ::: "memory");
#pragma unroll
            for (int r = 0; r < 16; ++r) { const float f = wsf[crow(r, hi)]; o0[r] *= f; o1[r] *= f; }
            v4u w0, w1, w2, w3;
            w0.x = cvtpk_s(p0[0], p0[1]); w0.y = cvtpk_s(p0[2], p0[3]); w0.z = cvtpk_s(p0[4], p0[5]); w0.w = cvtpk_s(p0[6], p0[7]);
            w1.x = cvtpk_s(p0[8], p0[9]); w1.y = cvtpk_s(p0[10], p0[11]); w1.z = cvtpk_s(p0[12], p0[13]); w1.w = cvtpk_s(p0[14], p0[15]);
            w2.x = cvtpk_s(p1[0], p1[1]); w2.y = cvtpk_s(p1[2], p1[3]); w2.z = cvtpk_s(p1[4], p1[5]); w2.w = cvtpk_s(p1[6], p1[7]);
            w3.x = cvtpk_s(p1[8], p1[9]); w3.y = cvtpk_s(p1[10], p1[11]); w3.z = cvtpk_s(p1[12], p1[13]); w3.w = cvtpk_s(p1[14], p1[15]);
            bf16x8 pa[4]; pa[0] = __builtin_bit_cast(bf16x8, w0); pa[1] = __builtin_bit_cast(bf16x8, w1); pa[2] = __builtin_bit_cast(bf16x8, w2); pa[3] = __builtin_bit_cast(bf16x8, w3);
            const LAS unsigned char* vp = lds + V_OFF + buf + ((lane >> 4) & 1) * 32 + (lane & 3) * 8 + (4 * hi + ((lane & 15) >> 2)) * 64;
#pragma unroll
            for (int ks = 0; ks < 4; ++ks) {
                const s16x4 l0 = vtr(vp + ks * 1024), h0 = vtr(vp + ks * 1024 + 512), l1 = vtr(vp + 4096 + ks * 1024), h1 = vtr(vp + 4096 + ks * 1024 + 512);
                const bf16x8 f0 = __builtin_shufflevector(l0, h0, 0, 1, 2, 3, 4, 5, 6, 7), f1 = __builtin_shufflevector(l1, h1, 0, 1, 2, 3, 4, 5, 6, 7);
                o0 = MFMA32(pa[ks], f0, o0); o1 = MFMA32(pa[ks], f1, o1); }
        }
    }
    { const float lt = lrun + __shfl_xor(lrun, 32);
      if (hi == 0) wsf[32 + r32] = 1.0f / lt;
      asm volatile("s_waitcnt lgkmcnt(0)" ::: "memory");
      bf16* Ow = O + rowq * DM + h * HD;
#pragma unroll
      for (int r = 0; r < 16; ++r) { const int q = crow(r, hi); const float f = wsf[32 + q];
          Ow[(size_t)q * DM + r32] = (bf16)f2bf(o0[r] * f); Ow[(size_t)q * DM + 32 + r32] = (bf16)f2bf(o1[r] * f); } }
    __syncthreads();
}
__device__ __forceinline__ void attn_phase(Frame& F, const bf16* Q, const bf16* K, const bf16* V, bf16* O, const float* rel_bias) {
    for (int u = F.vcu; u < NB * NH * (SEQ / 256); u += F.G) {
        const int bh = (u & 255) >> 2, qblk = ((u & 3) << 3) + (u >> 8);
        attn_unit(F.lds + RING_OFF, Q, K, V, O, rel_bias, bh >> 4, bh & 15, qblk);
    }
}
}
namespace ssd {
constexpr int LDT = 72;
constexpr int LDC = 136;
__device__ __forceinline__ void s1_unit(LAS unsigned char* lds, const bf16* XBC, const float* DT, const float* A_log, bf16* ST, int b, int h, int nq) {
    const int tid = threadIdx.x, lane = tid & 63, fr = lane & 15, fq = lane >> 4; const int wid = __builtin_amdgcn_readfirstlane(tid >> 6);
    const int g = h >> 3, nt = wid & 1, pt = wid >> 1;
    const float Ah = -__expf(A_log[h]);
    LAS bf16* BT = (LAS bf16*)lds; LAS bf16* XdT = (LAS bf16*)(lds + 4608); LAS float* scal = (LAS float*)(lds + 13824);
    f32x4 hst = {0.f, 0.f, 0.f, 0.f};
    const int lB = tid >> 2, n8 = (tid & 3) * 8, lX = tid >> 3, p8 = (tid & 7) * 8;
    for (int c = 0; c < 128; ++c) {
        const size_t row0 = (size_t)b * SEQ + (size_t)c * 64;
        v4u bv = {0u, 0u, 0u, 0u}; if (tid < 256) bv = *(const GAS v4u*)(XBC + (row0 + lB) * XBCW + 1024 + g * 128 + nq * 32 + n8);
        const v4u xv = *(const GAS v4u*)(XBC + (row0 + lX) * XBCW + h * 64 + p8);
        if (wid == 0) {
            const float dtv = DT[(row0 + lane) * 16 + h];
            float ac = dtv * Ah;
#pragma unroll
            for (int o = 1; o < 64; o <<= 1) { const float t = __shfl_up(ac, o); if (lane >= o) ac += t; }
            const float tot = __shfl(ac, 63);
            scal[lane] = dtv * __expf(tot - ac);
            if (lane == 0) scal[64] = __expf(tot);
        }
        __syncthreads();
        if (tid < 256) { const unsigned ww[4] = {bv.x, bv.y, bv.z, bv.w};
#pragma unroll
            for (int e = 0; e < 4; ++e) { BT[(n8 + 2 * e) * LDT + lB] = (bf16)(ww[e] & 0xffffu); BT[(n8 + 2 * e + 1) * LDT + lB] = (bf16)(ww[e] >> 16); } }
        { const float sc = scal[lX]; const unsigned ww[4] = {xv.x, xv.y, xv.z, xv.w};
#pragma unroll
          for (int e = 0; e < 4; ++e) { XdT[(p8 + 2 * e) * LDT + lX] = (bf16)f2bf(bflo(ww[e]) * sc); XdT[(p8 + 2 * e + 1) * LDT + lX] = (bf16)f2bf(bfhi(ww[e]) * sc); } }
        const float dec = scal[64];
        __syncthreads();
        { bf16* sp = ST + ((((size_t)b * 128 + c) * 16 + h) * 64 + (16 * pt + fr)) * 128 + 32 * nq + 16 * nt + 4 * fq;
          u32x2v o; o.x = cvtpk_s(hst[0], hst[1]); o.y = cvtpk_s(hst[2], hst[3]); *(GAS u32x2v*)sp = o; }
        f32x4 s = {0.f, 0.f, 0.f, 0.f};
#pragma unroll
        for (int kl = 0; kl < 2; ++kl) {
            const bf16x8 a = *(const LAS bf16x8*)(BT + (16 * nt + fr) * LDT + 32 * kl + 8 * fq), bb = *(const LAS bf16x8*)(XdT + (16 * pt + fr) * LDT + 32 * kl + 8 * fq);
            s = MFMA16(a, bb, s); }
        hst = hst * dec + s;
    }
    __syncthreads();
}
__device__ __forceinline__ void s2_unit(LAS unsigned char* lds, const bf16* XBC, const float* DT, const float* A_log, const float* Dskip, const float* normw, const bf16* ST, bf16* ZY, int b, int c, int g) {
    const int tid = threadIdx.x, lane = tid & 63, fr = lane & 15, fq = lane >> 4; const int wid = __builtin_amdgcn_readfirstlane(tid >> 6);
    const int h = g * 8 + wid;
    const size_t row0 = (size_t)b * SEQ + (size_t)c * 64;
    LAS bf16* Cs = (LAS bf16*)lds; LAS bf16* Bs = (LAS bf16*)(lds + 17408); LAS bf16* XT = (LAS bf16*)(lds + 34816 + wid * 9216);
    LAS float* acs = (LAS float*)(lds + 108544 + wid * 256); LAS float* dtl = (LAS float*)(lds + 110592 + wid * 256); LAS float* ssq = (LAS float*)(lds + 112640);
    const float Ah = -__expf(A_log[h]);
#pragma unroll
    for (int i = 0; i < 2; ++i) { const int idx = tid + 512 * i, l = idx >> 4, n8 = (idx & 15) * 8;
        const v4u cv = *(const GAS v4u*)(XBC + (row0 + l) * XBCW + 1280 + g * 128 + n8), bv = *(const GAS v4u*)(XBC + (row0 + l) * XBCW + 1024 + g * 128 + n8);
        *(LAS v4u*)(Cs + l * LDC + n8) = cv; *(LAS v4u*)(Bs + l * LDC + n8) = bv; }
    { const float dtv = DT[(row0 + lane) * 16 + h];
      float ac = dtv * Ah;
#pragma unroll
      for (int o = 1; o < 64; o <<= 1) { const float t = __shfl_up(ac, o); if (lane >= o) ac += t; }
      acs[lane] = ac; dtl[lane] = dtv; }
    __syncthreads();
#pragma unroll
    for (int i = 0; i < 8; ++i) { const int s = 8 * i + (lane >> 3), p8 = (lane & 7) * 8;
        const v4u xv = *(const GAS v4u*)(XBC + (row0 + s) * XBCW + h * 64 + p8); const float d = dtl[s]; const unsigned ww[4] = {xv.x, xv.y, xv.z, xv.w};
#pragma unroll
        for (int e = 0; e < 4; ++e) { XT[(p8 + 2 * e) * LDT + s] = (bf16)f2bf(bflo(ww[e]) * d); XT[(p8 + 2 * e + 1) * LDT + s] = (bf16)f2bf(bfhi(ww[e]) * d); } }
    __syncthreads();
    f32x4 acc[4][4];
#pragma unroll
    for (int pt = 0; pt < 4; ++pt)
#pragma unroll
        for (int lt = 0; lt < 4; ++lt) acc[pt][lt] = (f32x4){0.f, 0.f, 0.f, 0.f};
    { const bf16* hp = ST + ((((size_t)b * 128 + c) * 16 + h) * 64) * 128;
#pragma unroll
      for (int kn = 0; kn < 4; ++kn) {
          bf16x8 cf[4];
#pragma unroll
          for (int lt = 0; lt < 4; ++lt) cf[lt] = *(const LAS bf16x8*)(Cs + (16 * lt + fr) * LDC + 32 * kn + 8 * fq);
#pragma unroll
          for (int pt = 0; pt < 4; ++pt) { const bf16x8 hf = *(const GAS bf16x8*)(hp + (size_t)(16 * pt + fr) * 128 + 32 * kn + 8 * fq);
#pragma unroll
              for (int lt = 0; lt < 4; ++lt) acc[pt][lt] = MFMA16(hf, cf[lt], acc[pt][lt]); } }
#pragma unroll
      for (int lt = 0; lt < 4; ++lt) { const float ea = __expf(acs[16 * lt + fr]);
#pragma unroll
          for (int pt = 0; pt < 4; ++pt) acc[pt][lt] *= ea; } }
#pragma unroll
    for (int lt = 0; lt < 4; ++lt) { const int l = 16 * lt + fr; const float al = acs[l];
#pragma unroll
        for (int sp = 0; sp < 2; ++sp) { if (2 * sp <= lt) {
            f32x4 cb0 = {0.f, 0.f, 0.f, 0.f}, cb1 = {0.f, 0.f, 0.f, 0.f};
#pragma unroll
            for (int kn = 0; kn < 4; ++kn) { const bf16x8 cfr = *(const LAS bf16x8*)(Cs + (16 * lt + fr) * LDC + 32 * kn + 8 * fq);
                const bf16x8 b0 = *(const LAS bf16x8*)(Bs + (32 * sp + fr) * LDC + 32 * kn + 8 * fq), b1 = *(const LAS bf16x8*)(Bs + (32 * sp + 16 + fr) * LDC + 32 * kn + 8 * fq);
                cb0 = MFMA16(b0, cfr, cb0); cb1 = MFMA16(b1, cfr, cb1); }
            float g0[4], g1[4];
#pragma unroll
            for (int r = 0; r < 4; ++r) { const int s0 = 32 * sp + 4 * fq + r, s1 = s0 + 16;
                const float e0 = __expf(al - acs[s0]), e1 = __expf(al - acs[s1]);
                g0[r] = (s0 <= l) ? cb0[r] * e0 : 0.f; g1[r] = (s1 <= l) ? cb1[r] * e1 : 0.f; }
            v4u gw; gw.x = cvtpk_s(g0[0], g0[1]); gw.y = cvtpk_s(g0[2], g0[3]); gw.z = cvtpk_s(g1[0], g1[1]); gw.w = cvtpk_s(g1[2], g1[3]);
            const bf16x8 gf = __builtin_bit_cast(bf16x8, gw);
#pragma unroll
            for (int pt = 0; pt < 4; ++pt) { const u32x2v lo = *(const LAS u32x2v*)(XT + (16 * pt + fr) * LDT + 32 * sp + 4 * fq), hi2 = *(const LAS u32x2v*)(XT + (16 * pt + fr) * LDT + 32 * sp + 16 + 4 * fq);
                v4u xw; xw.x = lo.x; xw.y = lo.y; xw.z = hi2.x; xw.w = hi2.y;
                acc[pt][lt] = MFMA16(__builtin_bit_cast(bf16x8, xw), gf, acc[pt][lt]); }
        } } }
    const float Dh = Dskip[h];
#pragma unroll
    for (int lt = 0; lt < 4; ++lt) { const int l = 16 * lt + fr; float ss = 0.f;
#pragma unroll
        for (int pt = 0; pt < 4; ++pt) { const int p0 = 16 * pt + 4 * fq;
            const u32x2v xr = *(const GAS u32x2v*)(XBC + (row0 + l) * XBCW + h * 64 + p0), zr = *(const GAS u32x2v*)(ZY + (row0 + l) * DM + h * 64 + p0);
            const float xs[4] = {bflo(xr.x), bfhi(xr.x), bflo(xr.y), bfhi(xr.y)}, zs[4] = {bflo(zr.x), bfhi(zr.x), bflo(zr.y), bfhi(zr.y)};
#pragma unroll
            for (int r = 0; r < 4; ++r) { float y = acc[pt][lt][r] + Dh * xs[r]; y *= silu_f(zs[r]); acc[pt][lt][r] = y; ss += y * y; } }
        ss += __shfl_xor(ss, 16); ss += __shfl_xor(ss, 32);
        if (fq == 0) ssq[wid * 64 + l] = ss; }
    __syncthreads();
#pragma unroll
    for (int lt = 0; lt < 4; ++lt) { const int l = 16 * lt + fr; float tot = 0.f;
#pragma unroll
        for (int w = 0; w < 8; ++w) tot += ssq[w * 64 + l];
        const float rs = 1.0f / sqrtf(tot * (1.f / 512.f) + RMS_EPS);
#pragma unroll
        for (int pt = 0; pt < 4; ++pt) { const int p0 = 16 * pt + 4 * fq; const f32x4 nw = *(const GAS f32x4*)(normw + h * 64 + p0);
            u32x2v o; o.x = cvtpk_s(acc[pt][lt][0] * rs * nw[0], acc[pt][lt][1] * rs * nw[1]); o.y = cvtpk_s(acc[pt][lt][2] * rs * nw[2], acc[pt][lt][3] * rs * nw[3]);
            *(GAS u32x2v*)(ZY + (row0 + l) * DM + h * 64 + p0) = o; } }
    __syncthreads();
}
}

namespace naive {
__device__ __forceinline__ void conv_oop(Frame& F, const bf16* RAW, bf16* DST, const float* conv_w, const float* conv_b) {
    const int NIT = TOK * 192;
    for (int item = F.vcu * 512 + F.tid; item < NIT; item += F.G * 512) {
        const int row = item / 192, ch0 = (item - row * 192) * 8, t = row & (SEQ - 1);
        float y[8];
#pragma unroll
        for (int e = 0; e < 8; ++e) y[e] = conv_b[ch0 + e];
#pragma unroll
        for (int j = 0; j < 4; ++j) { const int tt = t - 3 + j; if (tt >= 0) { const v4u raw = *(const GAS v4u*)(RAW + (size_t)(row - 3 + j) * XBCW + ch0);
            const float c[8] = {bflo(raw.x), bfhi(raw.x), bflo(raw.y), bfhi(raw.y), bflo(raw.z), bfhi(raw.z), bflo(raw.w), bfhi(raw.w)};
#pragma unroll
            for (int e = 0; e < 8; ++e) y[e] += conv_w[j * XBCW + ch0 + e] * c[e]; } }
        v4u o; o.x = cvtpk_s(silu_f(y[0]), silu_f(y[1])); o.y = cvtpk_s(silu_f(y[2]), silu_f(y[3])); o.z = cvtpk_s(silu_f(y[4]), silu_f(y[5])); o.w = cvtpk_s(silu_f(y[6]), silu_f(y[7]));
        *(GAS v4u*)(DST + (size_t)row * XBCW + ch0) = o;
    }
}
__device__ __forceinline__ void ssd_seq(Frame& F, const bf16* XC, const float* DT, const float* A_log, const float* Dskip, const float* normw, bf16* ZY) {
    LAS float* red = (LAS float*)(F.lds + RING_OFF);
    for (int u = F.vcu; u < NB * NGRP; u += F.G) {
        const int b = u >> 1, g = u & 1, h = g * 8 + F.wave, p = F.lane;
        const float Ah = -__expf(A_log[h]), Dh = Dskip[h], nw = normw[h * 64 + p];
        float hs[128];
#pragma unroll
        for (int n = 0; n < 128; ++n) hs[n] = 0.f;
        for (int t = 0; t < SEQ; ++t) {
            const size_t row = (size_t)b * SEQ + t;
            const float dt = DT[row * 16 + h];
            const float dec = __expf(dt * Ah);
            const float xv = bflo((unsigned)XC[row * XBCW + h * 64 + p]);
            const float dx = dt * xv;
            float y = 0.f;
#pragma unroll
            for (int n8 = 0; n8 < 16; ++n8) {
                const v4u bw = *(const GAS v4u*)(XC + row * XBCW + 1024 + g * 128 + n8 * 8), cw = *(const GAS v4u*)(XC + row * XBCW + 1280 + g * 128 + n8 * 8);
                const float bb[8] = {bflo(bw.x), bfhi(bw.x), bflo(bw.y), bfhi(bw.y), bflo(bw.z), bfhi(bw.z), bflo(bw.w), bfhi(bw.w)};
                const float cc[8] = {bflo(cw.x), bfhi(cw.x), bflo(cw.y), bfhi(cw.y), bflo(cw.z), bfhi(cw.z), bflo(cw.w), bfhi(cw.w)};
#pragma unroll
                for (int e = 0; e < 8; ++e) { hs[n8 * 8 + e] = hs[n8 * 8 + e] * dec + dx * bb[e]; y += cc[e] * hs[n8 * 8 + e]; }
            }
            y += Dh * xv;
            const float zv = bflo((unsigned)ZY[row * DM + h * 64 + p]);
            y *= silu_f(zv);
            const float ss = wave_sum(y * y);
            if (F.lane == 0) red[(t & 1) * 8 + F.wave] = ss;
            __syncthreads();
            float tot = 0.f;
#pragma unroll
            for (int w = 0; w < 8; ++w) tot += red[(t & 1) * 8 + w];
            const float rs = 1.0f / sqrtf(tot * (1.f / 512.f) + RMS_EPS);
            ZY[row * DM + h * 64 + p] = (bf16)f2bf(y * rs * nw);
        }
        __syncthreads();
    }
}
__device__ __forceinline__ void attn_seq(Frame& F, const bf16* Q, const bf16* K, const bf16* V, bf16* O, const float* rel_bias) {
    for (int item = F.vcu * 512 + F.tid; item < TOK * NH; item += F.G * 512) {
        const int row = item >> 4, h = item & 15, t = row & (SEQ - 1), b = row >> 13;
        float q[64], acc[64];
#pragma unroll
        for (int d8 = 0; d8 < 8; ++d8) { const v4u w = *(const GAS v4u*)(Q + (size_t)row * DM + h * 64 + d8 * 8);
            q[d8 * 8 + 0] = bflo(w.x); q[d8 * 8 + 1] = bfhi(w.x); q[d8 * 8 + 2] = bflo(w.y); q[d8 * 8 + 3] = bfhi(w.y); q[d8 * 8 + 4] = bflo(w.z); q[d8 * 8 + 5] = bfhi(w.z); q[d8 * 8 + 6] = bflo(w.w); q[d8 * 8 + 7] = bfhi(w.w); }
#pragma unroll
        for (int d = 0; d < 64; ++d) acc[d] = 0.f;
        float m = -INFINITY, l = 0.f;
        const int c = t >> 6; int j0 = (c - 8) * 64; if (j0 < 0) j0 = 0; const int j1 = c * 64 + 64;
        for (int j = j0; j < j1; ++j) {
            const size_t kr = (size_t)b * SEQ + j;
            float s = 0.f;
#pragma unroll
            for (int d8 = 0; d8 < 8; ++d8) { const v4u w = *(const GAS v4u*)(K + kr * DM + h * 64 + d8 * 8);
                s += q[d8 * 8 + 0] * bflo(w.x) + q[d8 * 8 + 1] * bfhi(w.x) + q[d8 * 8 + 2] * bflo(w.y) + q[d8 * 8 + 3] * bfhi(w.y) + q[d8 * 8 + 4] * bflo(w.z) + q[d8 * 8 + 5] * bfhi(w.z) + q[d8 * 8 + 6] * bflo(w.w) + q[d8 * 8 + 7] * bfhi(w.w); }
            int rel = t - j; rel = rel < -128 ? -128 : (rel > 128 ? 128 : rel);
            s += rel_bias[h * 257 + rel + 128] * LOG2E;
            const float mn = fmaxf(m, s), al = __builtin_amdgcn_exp2f(m - mn), pw = __builtin_amdgcn_exp2f(s - mn);
            m = mn; l = l * al + pw;
#pragma unroll
            for (int d8 = 0; d8 < 8; ++d8) { const v4u w = *(const GAS v4u*)(V + kr * DM + h * 64 + d8 * 8);
                acc[d8 * 8 + 0] = acc[d8 * 8 + 0] * al + pw * bflo(w.x); acc[d8 * 8 + 1] = acc[d8 * 8 + 1] * al + pw * bfhi(w.x); acc[d8 * 8 + 2] = acc[d8 * 8 + 2] * al + pw * bflo(w.y); acc[d8 * 8 + 3] = acc[d8 * 8 + 3] * al + pw * bfhi(w.y);
                acc[d8 * 8 + 4] = acc[d8 * 8 + 4] * al + pw * bflo(w.z); acc[d8 * 8 + 5] = acc[d8 * 8 + 5] * al + pw * bfhi(w.z); acc[d8 * 8 + 6] = acc[d8 * 8 + 6] * al + pw * bflo(w.w); acc[d8 * 8 + 7] = acc[d8 * 8 + 7] * al + pw * bfhi(w.w); }
        }
        const float inv = 1.0f / l;
#pragma unroll
        for (int d8 = 0; d8 < 8; ++d8) { v4u o; o.x = cvtpk_s(acc[d8 * 8 + 0] * inv, acc[d8 * 8 + 1] * inv); o.y = cvtpk_s(acc[d8 * 8 + 2] * inv, acc[d8 * 8 + 3] * inv); o.z = cvtpk_s(acc[d8 * 8 + 4] * inv, acc[d8 * 8 + 5] * inv); o.w = cvtpk_s(acc[d8 * 8 + 6] * inv, acc[d8 * 8 + 7] * inv);
            *(GAS v4u*)(O + (size_t)row * DM + h * 64 + d8 * 8) = o; }
    }
}
}

namespace chk {
constexpr int CW_FLAG = 2048;
__device__ __forceinline__ float bfr(float w) { return __uint_as_float(f2bf(w) << 16); }
__device__ __forceinline__ float ldb(const bf16* p) { return __uint_as_float(((unsigned)*p) << 16); }
__device__ __forceinline__ float dotw(const bf16* Arow, const float* W, int N, int col, int K, int lane) {
    float s = 0.f; for (int k = lane; k < K; k += 64) s += ldb(Arow + k) * bfr(W[(size_t)k * N + col]); return wave_sum(s);
}
__device__ __forceinline__ void flag(Frame& F, int bit, bool bad) { if (bad && F.lane == 0) atomicOr((unsigned*)(F.ctl + CW_FLAG), 1u << bit); }
__device__ __forceinline__ bool far(float got, float want, float rel, float abs_) { const float e = fabsf(got - want); return !(e <= rel * fabsf(want) + abs_); }
__device__ __forceinline__ void pick(Frame& F, int N, int salt, int& row, int& col) {
    const unsigned gw = (unsigned)(F.vcu * NWAVES + F.wave); unsigned h = (gw + 1u) * 2654435761u + (unsigned)salt * 40503u; h ^= h >> 15; h *= 2246822519u; h ^= h >> 13;
    row = (int)(h % (unsigned)TOK); col = (int)((h >> 8) % (unsigned)N);
}
__device__ __forceinline__ void c_up(Frame& F, int bit, const bf16* XN, const float* wgu, const bf16* ACT) {
    int row, col; pick(F, FF, bit, row, col);
    const float g = dotw(XN + (size_t)row * DM, wgu, 2 * FF, col, DM, F.lane), u = dotw(XN + (size_t)row * DM, wgu, 2 * FF, FF + col, DM, F.lane);
    flag(F, bit, far(ldb(ACT + (size_t)row * FF + col), silu_f(g) * u, 0.03f, 0.01f));
}
__device__ __forceinline__ void c_down(Frame& F, int bit, const float* base, const bf16* ACT, const float* wd, const float* out) {
    int row, col; pick(F, DM, bit, row, col);
    const float d = dotw(ACT + (size_t)row * FF, wd, DM, col, FF, F.lane);
    flag(F, bit, far(out[(size_t)row * DM + col], base[(size_t)row * DM + col] + 0.5f * d, 0.f, 0.02f));
}
__device__ __forceinline__ void c_norm(Frame& F, int bit, const float* src, const float* w, const bf16* XN) {
    int row, col; pick(F, DM, bit, row, col);
    float s = 0.f; for (int k = F.lane; k < DM; k += 64) { const float v = src[(size_t)row * DM + k]; s += v * v; } s = wave_sum(s);
    const float want = src[(size_t)row * DM + col] / sqrtf(s / DM + RMS_EPS) * w[col];
    flag(F, bit, far(ldb(XN + (size_t)row * DM + col), want, 0.02f, 0.01f));
}
__device__ __forceinline__ void c_in1(Frame& F, int bit, const bf16* XN, const float* win, const bf16* Z, const bf16* XBC, const bf16* Q, const bf16* K, const bf16* V, const float* DT, const float* dt_bias) {
    int row, sc; pick(F, 5648, bit, row, sc);
    const float d = dotw(XN + (size_t)row * DM, win, 7696, sc, DM, F.lane);
    float got, want = d;
    if (sc < 1024) got = ldb(Z + (size_t)row * DM + sc);
    else if (sc < 2560) got = ldb(XBC + (size_t)row * XBCW + (sc - 1024));
    else if (sc < 2576) { got = DT[(size_t)row * 16 + (sc - 2560)]; const float xx = d + dt_bias[sc - 2560]; want = fmaxf(xx, 0.f) + log1pf(__expf(-fabsf(xx))); }
    else if (sc < 3600) { got = ldb(Q + (size_t)row * DM + (sc - 2576)); want = d * QSCALE; }
    else if (sc < 4624) got = ldb(K + (size_t)row * DM + (sc - 3600));
    else got = ldb(V + (size_t)row * DM + (sc - 4624));
    flag(F, bit, far(got, want, 0.03f, 0.02f));
}
__device__ __forceinline__ void c_gate(Frame& F, int bit, const bf16* XN, const float* win, const bf16* G) {
    int row, col; pick(F, NGATE, bit, row, col);
    const float d = dotw(XN + (size_t)row * DM, win, 7696, 5648 + col, DM, F.lane);
    const bool bad = far(ldb(G + (size_t)row * NGATE + col), sigm_f(d), 0.02f, 0.01f);
    flag(F, bit, bad);
}
__device__ __forceinline__ void c_merge(Frame& F, int bit, const bf16* YS, const bf16* YA, const bf16* G, const float* wbs, const float* wba, const bf16* MG) {
    int row, col; pick(F, DM, bit, row, col);
    const float a = dotw(YS + (size_t)row * DM, wbs, DM, col, DM, F.lane), c = dotw(YA + (size_t)row * DM, wba, DM, col, DM, F.lane);
    const float want = ldb(G + (size_t)row * NGATE + col) * a + ldb(G + (size_t)row * NGATE + DM + col) * c;
    flag(F, bit, far(ldb(MG + (size_t)row * DM + col), want, 0.03f, 0.02f));
}
__device__ __forceinline__ void c_wt(Frame& F, const float* win, const bf16* Wt) {
    int k, j; pick(F, NGATE, 77, k, j); k &= (DM - 1);
    unsigned bad = 0;
    for (int kk = F.lane; kk < DM; kk += 64) { const float want = bfr(win[(size_t)kk * 7696 + 5648 + j]); const float got = ldb(Wt + (size_t)(5888 + j) * DM + kk); if (got != want) bad = 1; }
    bad = (unsigned)(__ballot(bad) != 0ull);
    if (bad && F.lane == 0) atomicAdd((unsigned*)(F.ctl + CW_FLAG + 64), 1u);
}
}

struct Args { const float* in[20]; float* out; unsigned char* ws; int ph_lo, ph_hi, li, pad; };
__global__ void __launch_bounds__(NWAVES * 64, 2) fwd_kernel(Args args) {
    extern __shared__ __attribute__((aligned(16))) unsigned char lds[];
    Frame F;
    F.lds = (LAS unsigned char*)lds;
    F.MISC = (volatile LAS unsigned*)(F.lds + MISC_OFF);
    F.tid = threadIdx.x; F.lane = F.tid & 63; F.wave = __builtin_amdgcn_readfirstlane(F.tid >> 6);
    F.G = gridDim.x; { const int bx = blockIdx.x; F.vcu = (F.G % 8 == 0) ? (bx % 8) * (F.G / 8) + bx / 8 : bx; }
    unsigned char* ws = args.ws;
    F.ctl = (gu32*)(ws + WS_CTL);
    for (int u = F.tid; u < (LDS_BYTES - LDSCTL_OFF) / 4; u += NWAVES * 64) ((LAS unsigned*)(F.lds + LDSCTL_OFF))[u] = 0u;
    __syncthreads();
    XcdBarrier bar; bar.bar = (unsigned*)(F.ctl + CW_BAR); bar.x = 0; bar.st = nullptr;
    if (N_LAUNCHES == 1) bar = xcd_barrier_post((unsigned*)(F.ctl + CW_BAR), F.MISC + 8);
#define GRID_BAR() do { if (N_LAUNCHES == 1) xcd_barrier(bar); } while (0)
    const float* x = args.in[0]; float* out = args.out;
    bf16* Wgu1 = (bf16*)(ws + WS_WGU1); bf16* Wd1 = (bf16*)(ws + WS_WD1); bf16* Win = (bf16*)(ws + WS_WIN); bf16* Wbs = (bf16*)(ws + WS_WBS); bf16* Wba = (bf16*)(ws + WS_WBA);
    bf16* Wout = (bf16*)(ws + WS_WOUT); bf16* Wgu2 = (bf16*)(ws + WS_WGU2); bf16* Wd2 = (bf16*)(ws + WS_WD2);
    bf16* XN = (bf16*)(ws + WS_XN); bf16* ZB = (bf16*)(ws + WS_Z); bf16* XBC = (bf16*)(ws + WS_XBC); bf16* QB = (bf16*)(ws + WS_Q); bf16* KB = (bf16*)(ws + WS_K); bf16* VB = (bf16*)(ws + WS_V);
    float* DT = (float*)(ws + WS_DT); bf16* HALO = (bf16*)(ws + WS_HALO); bf16* ACT = (bf16*)(ws + WS_ACT); bf16* ST = (bf16*)(ws + WS_ST); bf16* GB = (bf16*)(ws + WS_G); bf16* MS = (bf16*)(ws + WS_MS);
    const int lo = args.ph_lo, hi = args.ph_hi;
#define IN(k) (lo <= (k) && (k) < hi)
#define SEAM(k) do { if (IN(k) && IN((k) + 1)) GRID_BAR(); } while (0)
    const int bx = (int)blockIdx.x;

    if (IN(0)) { P0Args a{x, args.in[1], args.in[2], args.in[3], args.in[5], args.in[13], args.in[14], args.in[15], args.in[17], args.in[18], Wgu1, Wd1, Win, Wbs, Wba, Wout, Wgu2, Wd2, XN};
        p0_prologue(F, a); }
    SEAM(0);
#if DBG_CHK
    if (IN(1)) chk::c_norm(F, 0, x, args.in[1], XN);
    if (IN(2)) chk::c_up(F, 1, XN, args.in[2], ACT);
    if (IN(3)) chk::c_down(F, 2, x, ACT, args.in[3], out);
    if (IN(4)) chk::c_norm(F, 3, out, args.in[4], XN);
    if (IN(5)) chk::c_in1(F, 4, XN, args.in[5], ZB, XBC, QB, KB, VB, DT, args.in[8]);
    if (IN(9)) { chk::c_gate(F, 5, XN, args.in[5], GB); chk::c_wt(F, args.in[5], Win); }
    if (IN(11)) chk::c_merge(F, 6, ZB, QB, GB, args.in[13], args.in[14], XN);
    if (IN(13)) chk::c_norm(F, 7, out, args.in[16], XN);
    if (IN(14)) chk::c_up(F, 8, XN, args.in[17], ACT);
#endif
    if (IN(1)) { pg8::Gemm g{XN, Wgu1, TOK, 2 * FF, DM}; pg8::StaticOrder S; S.init(TOK, 2 * FF, F.G, bx); pg8::EpiSwiglu E{ACT};
        pg8::gemm_phase<pg8::EpiSwiglu, pg8::StaticOrder, true, true>(F.lds + RING_OFF, g, S, E); }
    SEAM(1);
    if (IN(2)) { pg8::Gemm g{ACT, Wd1, TOK, DM, FF}; pg8::StaticOrder S; S.init(TOK, DM, F.G, bx); pg8::EpiResid E{x, out, 0.5f};
        pg8::gemm_phase<pg8::EpiResid, pg8::StaticOrder, true, true>(F.lds + RING_OFF, g, S, E); }
    SEAM(2);
    if (IN(3)) norm_pass(F, out, args.in[4], XN);
    SEAM(3);
    if (IN(4)) { pg8::Gemm g{XN, Win, TOK, NIN1, DM}; pg8::StaticOrder S; S.init(TOK, NIN1, F.G, bx); pg8::EpiIn1 E{ZB, XBC, QB, KB, VB, HALO, DT, args.in[8]};
        pg8::gemm_phase<pg8::EpiIn1, pg8::StaticOrder, true, true>(F.lds + RING_OFF, g, S, E); }
    SEAM(4);
    if (IN(5)) {
#if !DBG_SSD
        conv_pass(F, XBC, HALO, args.in[6], args.in[7]);
#endif
#if DBG_ATT
        naive::attn_seq(F, QB, KB, VB, QB, args.in[12]);
#else
        att::attn_phase(F, QB, KB, VB, QB, args.in[12]);
#endif
    }
    SEAM(5);
#if DBG_SSD
    if (IN(6)) naive::conv_oop(F, XBC, KB, args.in[6], args.in[7]);
#else
    if (IN(6)) { for (int u = F.vcu; u < NB * NH * 4; u += F.G) ssd::s1_unit(F.lds + RING_OFF, XBC, DT, args.in[9], ST, u >> 6, (u >> 2) & 15, u & 3); }
#endif
    SEAM(6);
#if DBG_SSD
    if (IN(7)) naive::ssd_seq(F, KB, DT, args.in[9], args.in[10], args.in[11], ZB);
#else
    if (IN(7)) { for (int u = F.vcu; u < NB * 128 * NGRP; u += F.G) ssd::s2_unit(F.lds + RING_OFF, XBC, DT, args.in[9], args.in[10], args.in[11], ST, ZB, u >> 8, (u >> 1) & 127, u & 1); }
#endif
    SEAM(7);
    if (IN(8)) { pg8::Gemm g{XN, Win + (size_t)NIN1 * DM, TOK, NGATE, DM}; pg8::StaticOrder S; S.init(TOK, NGATE, F.G, bx); pg8::EpiGate E{GB};
        pg8::gemm_phase<pg8::EpiGate, pg8::StaticOrder, true, true>(F.lds + RING_OFF, g, S, E); }
    SEAM(8);
    if (IN(9)) { pg8::Gemm g{ZB, Wbs, TOK, DM, DM}; pg8::StaticOrder S; S.init(TOK, DM, F.G, bx); pg8::EpiMerge<false> E{GB, nullptr, MS};
        pg8::gemm_phase<pg8::EpiMerge<false>, pg8::StaticOrder, true, true>(F.lds + RING_OFF, g, S, E); }
    if (IN(10)) { pg8::Gemm g{QB, Wba, TOK, DM, DM}; pg8::StaticOrder S; S.init(TOK, DM, F.G, bx); pg8::EpiMerge<true> E{GB + DM, MS, XN};
        pg8::gemm_phase<pg8::EpiMerge<true>, pg8::StaticOrder, true, true>(F.lds + RING_OFF, g, S, E); }
    SEAM(10);
    if (IN(11)) { pg8::Gemm g{XN, Wout, TOK, DM, DM}; pg8::StaticOrder S; S.init(TOK, DM, F.G, bx); pg8::EpiResid E{out, out, 1.0f};
        pg8::gemm_phase<pg8::EpiResid, pg8::StaticOrder, true, true>(F.lds + RING_OFF, g, S, E); }
    SEAM(11);
    if (IN(12)) norm_pass(F, out, args.in[16], XN);
    SEAM(12);
    if (IN(13)) { pg8::Gemm g{XN, Wgu2, TOK, 2 * FF, DM}; pg8::StaticOrder S; S.init(TOK, 2 * FF, F.G, bx); pg8::EpiSwiglu E{ACT};
        pg8::gemm_phase<pg8::EpiSwiglu, pg8::StaticOrder, true, true>(F.lds + RING_OFF, g, S, E); }
    SEAM(13);
    if (IN(14)) { pg8::Gemm g{ACT, Wd2, TOK, DM, FF}; pg8::StaticOrder S; S.init(TOK, DM, F.G, bx); pg8::EpiResid E{out, out, 0.5f};
        pg8::gemm_phase<pg8::EpiResid, pg8::StaticOrder, true, true>(F.lds + RING_OFF, g, S, E); }
    SEAM(14);
    if (IN(15)) { const int gw = F.vcu * NWAVES + F.wave, NGW = F.G * NWAVES; for (int m = gw; m < TOK; m += NGW) rms_row_f32_inplace(F.lane, out + (size_t)m * DM, args.in[19]);
#if DBG_CHK
        { const unsigned fl = __hip_atomic_load(F.ctl + chk::CW_FLAG, RLX_AGENT); const unsigned cnt = __hip_atomic_load(F.ctl + chk::CW_FLAG + 64, RLX_AGENT); const float sc = 1.0f + 0.5f * (float)(cnt ? 32 - __builtin_clz(cnt) : (fl ? __builtin_ctz(fl) + 1 : 0));
          for (int m = gw; m < TOK; m += NGW) { GAS f32x4* xr = (GAS f32x4*)(out + (size_t)m * DM) + F.lane; for (int j = 0; j < 4; ++j) xr[64 * j] = xr[64 * j] * sc; } }
#endif
    }
#undef IN
#undef SEAM
#undef GRID_BAR
}

extern "C" void kernel_launch(void* const* d_in, const int* in_sizes, int n_in, void* d_out, int out_size, void* d_ws, size_t ws_size, hipStream_t stream) {
    static int grid = 0;
    if (grid == 0) {
        if (n_in != 20 || in_sizes[0] != TOK * DM || out_size != TOK * DM || ws_size < WS_END) { fprintf(stderr, "kernel_launch: unexpected shapes (n_in %d, in0 %d, out %d, ws %zu)\n", n_in, n_in > 0 ? in_sizes[0] : -1, out_size, ws_size); grid = -1; return; }
        int dev = 0, cus = 0, per_cu = 0;
        if (hipGetDevice(&dev) != hipSuccess || hipDeviceGetAttribute(&cus, hipDeviceAttributeMultiprocessorCount, dev) != hipSuccess) { grid = -1; return; }
        if (hipFuncSetAttribute((const void*)fwd_kernel, hipFuncAttributeMaxDynamicSharedMemorySize, LDS_BYTES) != hipSuccess) { fprintf(stderr, "kernel_launch: hipFuncSetAttribute failed\n"); grid = -1; return; }
        if (hipOccupancyMaxActiveBlocksPerMultiprocessor(&per_cu, (const void*)fwd_kernel, NWAVES * 64, LDS_BYTES) != hipSuccess || per_cu < 1) { fprintf(stderr, "kernel_launch: occupancy query says %d\n", per_cu); per_cu = 1; }
        (void)hipGetLastError();
        grid = cus;
    }
    if (grid < 0) return;
    if (hipMemsetAsync((char*)d_ws + WS_CTL, 0, CTL_ZERO_BYTES, stream) != hipSuccess) { fprintf(stderr, "kernel_launch: memset failed\n"); return; }
    Args a{};
    for (int i = 0; i < 20; ++i) a.in[i] = (const float*)d_in[i];
    a.out = (float*)d_out; a.ws = (unsigned char*)d_ws;
    if (N_LAUNCHES == 1) {
        a.ph_lo = 0; a.ph_hi = N_PHASES; a.li = 0;
        void* kargs[] = {&a};
        hipError_t e = hipLaunchCooperativeKernel((const void*)fwd_kernel, dim3(grid), dim3(NWAVES * 64), kargs, LDS_BYTES, stream);
        if (e != hipSuccess) fprintf(stderr, "kernel_launch: cooperative launch failed: %s (grid %d)\n", hipGetErrorString(e), grid);
    } else {
        for (int li = 0; li < N_PHASES; ++li) {
            a.ph_lo = li; a.ph_hi = li + 1; a.li = li;
            hipLaunchKernelGGL(fwd_kernel, dim3(grid), dim3(NWAVES * 64), LDS_BYTES, stream, a);
        }
    }
}
```

```cpp
#include <hip/hip_runtime.h>
#include <cstdio>
#include <cstdint>
#define MK_N_LAUNCHES 1
#define DBG_ATT 0
#define DBG_SSD 0
#define DBG_CHK 0
constexpr int NB = 4, SEQ = 8192, DM = 1024, NH = 16, HD = 64, FF = 2816, NST = 128, NGRP = 2;
constexpr int TOK = NB * SEQ;
constexpr int XBCW = 1536;
constexpr int NIN1 = 5888;
constexpr int NGATE = 2048;
constexpr int NCHUNK = TOK / 64;
constexpr float RMS_EPS = 1e-6f;
constexpr float LOG2E = 1.4426950408889634f;
constexpr float QSCALE = 0.125f * LOG2E;
namespace pg8 {
#define PG8_LAS __attribute__((address_space(3)))
typedef unsigned short bf16_t;
typedef short bf16x8 __attribute__((ext_vector_type(8)));
typedef float f32x4 __attribute__((ext_vector_type(4)));
typedef unsigned u32x4 __attribute__((ext_vector_type(4)));
constexpr int BM = 256, BK = 64, HALF = 128, HTB = HALF * BK * 2  , STAGE_BYTES = 8 * HTB, NXCD = 8, WGM = 8;

__host__ __device__ __forceinline__ int lds_byte(int r, int c) { const int st = (r >> 4) * 2 + (c >> 5), rr = r & 15, cc = c & 31, ob = rr * 64 + cc * 2; return st * 1024 + (ob ^ (((ob >> 9) & 1) << 5)); }
__host__ __device__ __forceinline__ void stage_rc(int b, int& R, int& C) { const int st = b / 1024, sb = b % 1024, swz = sb ^ (((sb >> 9) & 1) << 5); R = (st >> 1) * 16 + swz / 64; C = (st & 1) * 32 + (swz % 64) / 2; }
__host__ __device__ __forceinline__ int perm32(int rho) { const int n = rho >> 4, i = rho & 15; return 8 * (i >> 2) + 4 * n + (i & 3); }

struct Unit { int pm, pn; };
struct Gemm { const bf16_t* A; const bf16_t* Bt; int M, N, K; };

struct StaticOrder {
    int nM, nN, nwg, G, c;
    __host__ __device__ void init(int M, int N, int G_, int c_) { nM = M / BM; nN = N / BM; nwg = nM * nN; G = G_; c = c_; }
    __host__ __device__ bool next(int i, Unit& u) const {
        const long L = (long)i * G + c; if (L >= nwg) return false;
        int wgid = (int)L; { const int q = nwg / NXCD, r = nwg % NXCD, xcd = wgid % NXCD, off = wgid / NXCD; wgid = (xcd < r ? xcd * (q + 1) : r * (q + 1) + (xcd - r) * q) + off; }
        const int nig = WGM * nN, gid = wgid / nig, fm = gid * WGM, gsz = (nM - fm) < WGM ? (nM - fm) : WGM;
        u.pm = fm + ((wgid % nig) % gsz); u.pn = (wgid % nig) / gsz; return true;
    }
    __device__ __forceinline__ void a_ready(const Unit&) const {}
    __device__ __forceinline__ void done(const Unit&) const {}
};
typedef float f32x2 __attribute__((ext_vector_type(2)));
typedef __bf16 bf16x2v __attribute__((ext_vector_type(2)));
__device__ __forceinline__ unsigned cvt_pk_bf16(float lo, float hi) { f32x2 v = {lo, hi}; bf16x2v b = __builtin_convertvector(v, bf16x2v); return __builtin_bit_cast(unsigned, b); }
__device__ __forceinline__ float sigm(float x) { return __builtin_amdgcn_rcpf(1.0f + __builtin_amdgcn_exp2f(-x * 1.4426950408889634f)); }
__device__ __forceinline__ float silu(float x) { return x * sigm(x); }
__device__ __forceinline__ u32x4 pack8(const f32x4 a, const f32x4 b) { u32x4 w; w.x = cvt_pk_bf16(a[0], a[1]); w.y = cvt_pk_bf16(a[2], a[3]); w.z = cvt_pk_bf16(b[0], b[1]); w.w = cvt_pk_bf16(b[2], b[3]); return w; }
__device__ __forceinline__ float bf_lo(unsigned w) { return __uint_as_float(w << 16); }
__device__ __forceinline__ float bf_hi(unsigned w) { return __uint_as_float(w & 0xffff0000u); }
__device__ __forceinline__ void unpack8(const u32x4 w, f32x4& a, f32x4& b) { a[0] = bf_lo(w.x); a[1] = bf_hi(w.x); a[2] = bf_lo(w.y); a[3] = bf_hi(w.y); b[0] = bf_lo(w.z); b[1] = bf_hi(w.z); b[2] = bf_lo(w.w); b[3] = bf_hi(w.w); }
__device__ __forceinline__ float softplus_f(float x) { return fmaxf(x, 0.f) + log1pf(__expf(-fabsf(x))); }

struct EpiSwiglu {
    static constexpr bool PERM = true, AFTER_DRAIN = false;
    bf16_t* O;
    __device__ __forceinline__ void operator()(const f32x4 (&acc)[2][2][4][2], const Unit& u, int wr, int wc, int fr, int fq) const {
        const int row0 = u.pm * BM + wr * 64 + fr, col0 = u.pn * 128 + wc * 32 + 8 * fq;
#pragma unroll
        for (int ai = 0; ai < 2; ++ai)
#pragma unroll
            for (int m = 0; m < 4; ++m) { bf16_t* rowp = O + (size_t)(row0 + ai * HALF + m * 16) * FF + col0;
                f32x4 v0, v1;
#pragma unroll
                for (int j = 0; j < 4; ++j) { v0[j] = silu(acc[ai][0][m][0][j]) * acc[ai][1][m][0][j]; v1[j] = silu(acc[ai][0][m][1][j]) * acc[ai][1][m][1][j]; }
                *(u32x4*)rowp = pack8(v0, v1); }
    }
};
struct EpiResid {
    static constexpr bool PERM = false, AFTER_DRAIN = false;
    const float* base; float* out; float scale;
    __device__ __forceinline__ void operator()(const f32x4 (&acc)[2][2][4][2], const Unit& u, int wr, int wc, int fr, int fq) const {
        const int row0 = u.pm * BM + wr * 64 + fr, col0 = u.pn * BM + wc * 32 + 4 * fq;
#pragma unroll
        for (int ai = 0; ai < 2; ++ai)
#pragma unroll
            for (int m = 0; m < 4; ++m) { const size_t off = (size_t)(row0 + ai * HALF + m * 16) * DM + col0;
#pragma unroll
                for (int bj = 0; bj < 2; ++bj)
#pragma unroll
                    for (int n = 0; n < 2; ++n) { const size_t o = off + bj * HALF + n * 16; const f32x4 bs = *(const f32x4*)(base + o); *(f32x4*)(out + o) = bs + acc[ai][bj][m][n] * scale; }
                asm volatile("" ::: "memory"); }
    }
};
struct EpiIn1 {
    static constexpr bool PERM = true, AFTER_DRAIN = false;
    bf16_t *Z, *XBC, *Q, *K, *V, *HALO; float* DT; const float* dt_bias;
    __device__ __forceinline__ void operator()(const f32x4 (&acc)[2][2][4][2], const Unit& u, int wr, int wc, int fr, int fq) const {
        const int row0 = u.pm * BM + wr * 64 + fr, pn = u.pn, c8 = wc * 32 + 8 * fq;
        if (pn < 22) {
            bf16_t* base; int ld, colt; float sc = 1.f; bool halo = false;
            if (pn < 4) { base = Z; ld = DM; colt = pn * 256; }
            else if (pn < 10) { base = XBC; ld = XBCW; colt = (pn - 4) * 256; halo = true; }
            else if (pn < 14) { base = Q; ld = DM; colt = (pn - 10) * 256; sc = QSCALE; }
            else if (pn < 18) { base = K; ld = DM; colt = (pn - 14) * 256; }
            else { base = V; ld = DM; colt = (pn - 18) * 256; }
#pragma unroll
            for (int ai = 0; ai < 2; ++ai)
#pragma unroll
                for (int m = 0; m < 4; ++m) { const int row = row0 + ai * HALF + m * 16;
#pragma unroll
                    for (int bj = 0; bj < 2; ++bj) { const u32x4 w = pack8(acc[ai][bj][m][0] * sc, acc[ai][bj][m][1] * sc); const int col = colt + bj * HALF + c8;
                        *(u32x4*)(base + (size_t)row * ld + col) = w;
                        if (halo && (row & 63) >= 61) *(u32x4*)(HALO + (size_t)(((row >> 6) + 1) * 3 + ((row & 63) - 61)) * XBCW + col) = w; } }
        } else {
            if (wc == 0 && fq < 2) {
#pragma unroll
                for (int ai = 0; ai < 2; ++ai)
#pragma unroll
                    for (int m = 0; m < 4; ++m) { const int row = row0 + ai * HALF + m * 16;
#pragma unroll
                        for (int n = 0; n < 2; ++n) { const int i0 = 8 * fq + 4 * n; const f32x4 bv = *(const f32x4*)(dt_bias + i0); f32x4 o;
#pragma unroll
                            for (int j = 0; j < 4; ++j) o[j] = softplus_f(acc[ai][0][m][n][j] + bv[j]);
                            *(f32x4*)(DT + (size_t)row * 16 + i0) = o; } }
            }
        }
    }
};
struct EpiGate {
    static constexpr bool PERM = true, AFTER_DRAIN = false;
    bf16_t* G;
    __device__ __forceinline__ void operator()(const f32x4 (&acc)[2][2][4][2], const Unit& u, int wr, int wc, int fr, int fq) const {
        const int row0 = u.pm * BM + wr * 64 + fr, col0 = u.pn * BM + wc * 32 + 8 * fq;
#pragma unroll
        for (int ai = 0; ai < 2; ++ai)
#pragma unroll
            for (int m = 0; m < 4; ++m) { bf16_t* rowp = G + (size_t)(row0 + ai * HALF + m * 16) * NGATE + col0;
#pragma unroll
                for (int bj = 0; bj < 2; ++bj) { f32x4 v0, v1;
#pragma unroll
                    for (int j = 0; j < 4; ++j) { v0[j] = sigm(acc[ai][bj][m][0][j]); v1[j] = sigm(acc[ai][bj][m][1][j]); }
                    *(u32x4*)(rowp + bj * HALF) = pack8(v0, v1); } }
    }
};
template <bool ADD> struct EpiMerge {
    static constexpr bool PERM = true, AFTER_DRAIN = false;
    const bf16_t* G; const bf16_t* MS; bf16_t* O;
    __device__ __forceinline__ void operator()(const f32x4 (&acc)[2][2][4][2], const Unit& u, int wr, int wc, int fr, int fq) const {
        const int row0 = u.pm * BM + wr * 64 + fr, col0 = u.pn * BM + wc * 32 + 8 * fq;
#pragma unroll
        for (int ai = 0; ai < 2; ++ai)
#pragma unroll
            for (int m = 0; m < 4; ++m) { const size_t row = (size_t)(row0 + ai * HALF + m * 16);
#pragma unroll
                for (int bj = 0; bj < 2; ++bj) { const int col = col0 + bj * HALF;
                    f32x4 g0, g1; unpack8(*(const u32x4*)(G + row * NGATE + col), g0, g1);
                    f32x4 v0 = acc[ai][bj][m][0] * g0, v1 = acc[ai][bj][m][1] * g1;
                    if (ADD) { f32x4 m0, m1; unpack8(*(const u32x4*)(MS + row * DM + col), m0, m1); v0 += m0; v1 += m1; }
                    *(u32x4*)(O + row * DM + col) = pack8(v0, v1); } }
    }
};

template <class Epi, class Sched, bool ALIGN_EPI = false, bool SP2 = false>
__device__ __forceinline__ void gemm_phase(PG8_LAS unsigned char* lds, const Gemm g, const Sched& S, const Epi& E) {
    const int tid = threadIdx.x, wid = __builtin_amdgcn_readfirstlane(tid >> 6), lane = tid & 63, wr = wid >> 2, wc = wid & 3, fr = lane & 15, fq = lane >> 4;
    const int K = g.K, nt = K / BK;
    unsigned voffA[2], voffB[2];
#pragma unroll
    for (int i = 0; i < 2; ++i) { int R, C; stage_rc(tid * 16 + i * 8192, R, C); const int Rb = Epi::PERM ? ((R & ~31) + perm32(R & 31)) : R;
        voffA[i] = (unsigned)(R * K + C) * 2u; voffB[i] = (unsigned)(Rb * K + C) * 2u; }
    const size_t kstep = (size_t)(BK * 2);
    const size_t hstep = (size_t)HALF * K * 2;
    const size_t tstep = 2 * hstep;
    const unsigned ldsw = (unsigned)wid * 1024u;
    const int aoff = lds_byte(wr * 64 + fr, fq * 8), boff = lds_byte(wc * 32 + fr, fq * 8);
#define PG8_SA(b, h) (((b) * 2 + (h)) * HTB)
#define PG8_SB(b, h) ((4 + (b) * 2 + (h)) * HTB)
#define PG8_STAGE(bufoff, gbase, voff) do { _Pragma("unroll") for (int _i = 0; _i < 2; ++_i) \
        __builtin_amdgcn_global_load_lds((const unsigned*)((const char*)(gbase) + (voff)[_i]), (PG8_LAS unsigned*)(lds + (bufoff) + ldsw + _i * 8192), 16, 0, 0); } while (0)
#define PG8_LDA(dst, b, h) do { _Pragma("unroll") for (int m = 0; m < 4; ++m) _Pragma("unroll") for (int k = 0; k < 2; ++k) dst[m][k] = *(const PG8_LAS bf16x8*)(lds + PG8_SA(b, h) + aoff + m * 2048 + k * 1024); } while (0)
#define PG8_LDB(dst, b, h) do { _Pragma("unroll") for (int n = 0; n < 2; ++n) _Pragma("unroll") for (int k = 0; k < 2; ++k) dst[n][k] = *(const PG8_LAS bf16x8*)(lds + PG8_SB(b, h) + boff + n * 2048 + k * 1024); } while (0)
#define PG8_MMA(ai, bj, At, Bt) do { __builtin_amdgcn_s_setprio(1); _Pragma("unroll") for (int m = 0; m < 4; ++m) _Pragma("unroll") for (int n = 0; n < 2; ++n) _Pragma("unroll") for (int k = 0; k < 2; ++k) \
        acc[ai][bj][m][n] = __builtin_amdgcn_mfma_f32_16x16x32_bf16(Bt[n][k], At[m][k], acc[ai][bj][m][n], 0, 0, 0); __builtin_amdgcn_s_setprio(0); } while (0)
#define PG8_WAIT_V(n) asm volatile("s_waitcnt vmcnt(" #n ")" ::: "memory")
#define PG8_WAIT_L(n) asm volatile("s_waitcnt lgkmcnt(" #n ")" ::: "memory")
#define PG8_BAR __builtin_amdgcn_s_barrier()
#define PG8_SCHED __builtin_amdgcn_sched_barrier(0)
    Unit cur, nxt; int ui = 0;
    if (!S.next(0, cur)) return;
    f32x4 acc[2][2][4][2];
#pragma unroll
    for (int a = 0; a < 2; ++a)
#pragma unroll
        for (int b = 0; b < 2; ++b)
#pragma unroll
            for (int m = 0; m < 4; ++m)
#pragma unroll
                for (int n = 0; n < 2; ++n) acc[a][b][m][n] = (f32x4){0.f, 0.f, 0.f, 0.f};
    bf16x8 At[4][2], B0[2][2], B1[2][2];
    const char* cA = (const char*)g.A + (size_t)cur.pm * tstep; const char* cB = (const char*)g.Bt + (size_t)cur.pn * tstep;
    S.a_ready(cur);
    if constexpr (SP2) {
        PG8_STAGE(PG8_SB(0, 0), cB, voffB); PG8_STAGE(PG8_SB(0, 1), cB + hstep, voffB); PG8_STAGE(PG8_SA(0, 0), cA, voffA); PG8_STAGE(PG8_SA(0, 1), cA + hstep, voffA);
        if (wr == 1) PG8_BAR;
        PG8_WAIT_V(2); PG8_BAR;
        PG8_STAGE(PG8_SB(1, 0), cB + kstep, voffB); PG8_STAGE(PG8_SA(1, 0), cA + kstep, voffA); PG8_STAGE(PG8_SB(1, 1), cB + hstep + kstep, voffB);
        PG8_WAIT_V(6); PG8_BAR;
    } else {
        PG8_STAGE(PG8_SB(0, 0), cB, voffB); PG8_STAGE(PG8_SA(0, 0), cA, voffA); PG8_STAGE(PG8_SB(0, 1), cB + hstep, voffB); PG8_STAGE(PG8_SA(0, 1), cA + hstep, voffA);
        if (wr == 1) PG8_BAR;
        PG8_WAIT_V(4); PG8_BAR;
        PG8_STAGE(PG8_SB(1, 0), cB + kstep, voffB); PG8_STAGE(PG8_SA(1, 0), cA + kstep, voffA); PG8_STAGE(PG8_SB(1, 1), cB + hstep + kstep, voffB);
        PG8_WAIT_V(6); PG8_BAR;
    }
    for (;;) {
        const bool has_next = S.next(ui + 1, nxt);
        const char* nA = has_next ? (const char*)g.A + (size_t)nxt.pm * tstep : cA; const char* nB = has_next ? (const char*)g.Bt + (size_t)nxt.pn * tstep : cB;
        for (int t = 0; t < nt; t += 2) {
            const bool last = (t == nt - 2);
            const char* a1 = cA + (size_t)(t + 1) * kstep;
            const char* a2 = last ? nA : cA + (size_t)(t + 2) * kstep; const char* b2 = last ? nB : cB + (size_t)(t + 2) * kstep;
            const char* a3 = a2 + kstep; const char* b3 = b2 + kstep;
            if (last && has_next) S.a_ready(nxt);
            if constexpr (SP2) {
            PG8_LDB(B0, 0, 0); PG8_LDB(B1, 0, 1); PG8_SCHED; PG8_LDA(At, 0, 0); PG8_STAGE(PG8_SA(1, 1), a1 + hstep, voffA);
            PG8_WAIT_V(8); PG8_WAIT_L(0); PG8_BAR; PG8_MMA(0, 0, At, B0); PG8_MMA(0, 1, At, B1); PG8_BAR; PG8_SCHED;
            PG8_LDA(At, 0, 1); PG8_STAGE(PG8_SB(0, 0), b2, voffB); PG8_STAGE(PG8_SB(0, 1), b2 + hstep, voffB); PG8_STAGE(PG8_SA(0, 0), a2, voffA);
            PG8_WAIT_V(8); PG8_WAIT_L(0); PG8_BAR; PG8_MMA(1, 0, At, B0); PG8_MMA(1, 1, At, B1); PG8_BAR; PG8_SCHED;
            PG8_LDB(B0, 1, 0); PG8_LDB(B1, 1, 1); PG8_SCHED; PG8_LDA(At, 1, 0); PG8_STAGE(PG8_SA(0, 1), a2 + hstep, voffA);
            PG8_WAIT_V(8); PG8_WAIT_L(0); PG8_BAR; PG8_MMA(0, 0, At, B0); PG8_MMA(0, 1, At, B1); PG8_BAR; PG8_SCHED;
            PG8_LDA(At, 1, 1); PG8_STAGE(PG8_SB(1, 0), b3, voffB); PG8_STAGE(PG8_SB(1, 1), b3 + hstep, voffB); PG8_STAGE(PG8_SA(1, 0), a3, voffA);
            PG8_WAIT_V(8); PG8_WAIT_L(0); PG8_BAR; PG8_MMA(1, 0, At, B0); PG8_MMA(1, 1, At, B1); PG8_BAR; PG8_SCHED;
            } else {
            PG8_LDB(B0, 0, 0); PG8_SCHED; PG8_LDA(At, 0, 0); PG8_STAGE(PG8_SA(1, 1), a1 + hstep, voffA);
            PG8_WAIT_L(8); PG8_BAR; PG8_WAIT_L(0); PG8_MMA(0, 0, At, B0); PG8_BAR; PG8_SCHED;
            PG8_LDB(B1, 0, 1); PG8_STAGE(PG8_SB(0, 0), b2, voffB);
            PG8_BAR; PG8_WAIT_L(0); PG8_MMA(0, 1, At, B1); PG8_BAR;
            PG8_LDA(At, 0, 1); PG8_STAGE(PG8_SA(0, 0), a2, voffA);
            PG8_BAR; PG8_WAIT_L(0); PG8_MMA(1, 0, At, B0); PG8_BAR; PG8_SCHED;
            PG8_STAGE(PG8_SB(0, 1), b2 + hstep, voffB);
            PG8_WAIT_V(6); PG8_BAR; PG8_MMA(1, 1, At, B1); PG8_BAR;
            PG8_LDB(B0, 1, 0); PG8_SCHED; PG8_LDA(At, 1, 0); PG8_STAGE(PG8_SA(0, 1), a2 + hstep, voffA);
            PG8_WAIT_L(8); PG8_BAR; PG8_WAIT_L(0); PG8_MMA(0, 0, At, B0); PG8_BAR; PG8_SCHED;
            PG8_LDB(B1, 1, 1); PG8_STAGE(PG8_SB(1, 0), b3, voffB);
            PG8_BAR; PG8_WAIT_L(0); PG8_MMA(0, 1, At, B1); PG8_BAR;
            PG8_LDA(At, 1, 1); PG8_STAGE(PG8_SA(1, 0), a3, voffA);
            PG8_BAR; PG8_WAIT_L(0); PG8_MMA(1, 0, At, B0); PG8_BAR; PG8_SCHED;
            PG8_STAGE(PG8_SB(1, 1), b3 + hstep, voffB);
            PG8_WAIT_V(6); PG8_BAR; PG8_MMA(1, 1, At, B1); PG8_BAR;
            }
        }
        if constexpr (ALIGN_EPI) { if (wr == 0) PG8_BAR; }
        if constexpr (!Epi::AFTER_DRAIN) { E(acc, cur, wr, wc, fr, fq); S.done(cur); }
        if (!has_next) break;
#pragma unroll
        for (int a = 0; a < 2; ++a)
#pragma unroll
            for (int b = 0; b < 2; ++b)
#pragma unroll
                for (int m = 0; m < 4; ++m)
#pragma unroll
                    for (int n = 0; n < 2; ++n) acc[a][b][m][n] = (f32x4){0.f, 0.f, 0.f, 0.f};
        cur = nxt; cA = nA; cB = nB; ++ui;
        if constexpr (ALIGN_EPI) { if (wr == 1) PG8_BAR; }
    }
    PG8_WAIT_V(0);
    if constexpr (!ALIGN_EPI) { if (wr == 0) PG8_BAR; }
    PG8_BAR;
    if constexpr (Epi::AFTER_DRAIN) { E.fused(acc, cur, wr, wc, fr, fq, lds, wid, lane); S.done(cur); }
#undef PG8_SA
#undef PG8_SB
#undef PG8_STAGE
#undef PG8_LDA
#undef PG8_LDB
#undef PG8_MMA
#undef PG8_WAIT_V
#undef PG8_WAIT_L
#undef PG8_BAR
#undef PG8_SCHED
}
}
constexpr int NWAVES = 8;
#ifndef MK_N_LAUNCHES
#define MK_N_LAUNCHES 1
#endif
constexpr int N_PHASES = 16;
constexpr int N_LAUNCHES = MK_N_LAUNCHES;

constexpr size_t MiB = 1u << 20;
constexpr size_t WS_CTL = 0, CTL_ZERO_BYTES = 1 * MiB;
constexpr size_t WS_WGU1 = 1 * MiB;
constexpr size_t WS_WD1  = 12 * MiB;
constexpr size_t WS_WIN  = 18 * MiB;
constexpr size_t WS_WBS  = 34 * MiB, WS_WBA = 36 * MiB, WS_WOUT = 38 * MiB;
constexpr size_t WS_WGU2 = 40 * MiB, WS_WD2 = 51 * MiB;
constexpr size_t WS_XN   = 57 * MiB;
constexpr size_t WS_Z    = 121 * MiB;
constexpr size_t WS_XBC  = 185 * MiB;
constexpr size_t WS_Q    = 281 * MiB;
constexpr size_t WS_K    = 345 * MiB, WS_V = 409 * MiB;
constexpr size_t WS_DT   = 473 * MiB;
constexpr size_t WS_HALO = 475 * MiB;
constexpr size_t WS_ACT  = 121 * MiB;
constexpr size_t WS_ST   = 345 * MiB;
constexpr size_t WS_G    = 345 * MiB;
constexpr size_t WS_MS   = 185 * MiB;
constexpr size_t WS_END  = 480 * MiB;
constexpr int CW_BAR = 4096;

constexpr int RING_OFF = 0, RING_BYTES = 131072;
constexpr int LDSCTL_OFF = RING_BYTES, MISC_OFF = LDSCTL_OFF + 320;
constexpr int LDS_BYTES = 147456;

#define GAS __attribute__((address_space(1)))
#define LAS __attribute__((address_space(3)))
typedef unsigned short bf16;
typedef unsigned v4u __attribute__((ext_vector_type(4)));
typedef float f32x4 __attribute__((ext_vector_type(4)));
typedef short bf16x8 __attribute__((ext_vector_type(8)));
typedef GAS unsigned gu32;
typedef GAS unsigned long long gu64;
#define RLX_AGENT __ATOMIC_RELAXED, __HIP_MEMORY_SCOPE_AGENT
#define LDS_WAIT() asm volatile("s_waitcnt lgkmcnt(0)" ::: "memory")
#define VM_WAIT() asm volatile("s_waitcnt vmcnt(0)" ::: "memory")
__device__ __forceinline__ unsigned long long rt() { return __builtin_amdgcn_s_memrealtime(); }
__device__ __forceinline__ unsigned f2bf(float f) { unsigned u = __builtin_bit_cast(unsigned, f); return (u + 0x7fffu + ((u >> 16) & 1u)) >> 16; }
__device__ __forceinline__ unsigned pk2(float lo, float hi) { return f2bf(lo) | (f2bf(hi) << 16); }
#define XB_TMO      128
#define XB_XCNT(j)  (256  + 64 * (j))
#define XB_XSUB(j)  (1280 + 64 * (j))
#define XB_XGEN(j)  (2304 + 64 * (j))
#define XB_TOP      3328
#define XB_TOPGEN   3392
#define XCD_BAR_WORDS 3456
#define XB_SPIN_CAP (1u << 22)

__device__ __forceinline__ unsigned xb_ld(unsigned* p)              { return __hip_atomic_load(p, __ATOMIC_RELAXED, __HIP_MEMORY_SCOPE_AGENT); }
__device__ __forceinline__ unsigned xb_add(unsigned* p, unsigned v) { return __hip_atomic_fetch_add(p, v, __ATOMIC_RELAXED, __HIP_MEMORY_SCOPE_AGENT); }
__device__ __forceinline__ unsigned xb_xcc_id() { return (unsigned)__builtin_amdgcn_s_getreg((3 << 11) | 20) & 0xFu; }
#define XB_SPIN(cond, bar) do { unsigned _sp = 0; while (cond) { __builtin_amdgcn_s_sleep(1); \
    if ((++_sp & 255u) == 0u) { if (xb_ld(&(bar)[XB_TMO])) break; if (_sp > XB_SPIN_CAP) { atomicAdd(&(bar)[XB_TMO], 1u); break; } } } } while (0)

struct XcdBarrier {
    unsigned* bar; unsigned x;
    volatile LAS unsigned* st;
};

__device__ __forceinline__ XcdBarrier xcd_barrier_post(unsigned* bar, volatile LAS unsigned* st) {
    XcdBarrier b; b.bar = bar; b.x = xb_xcc_id(); b.st = st;
    if (threadIdx.x == 0) (void)xb_add(&bar[XB_XCNT(b.x)], 1u);
    return b;
}
__device__ __forceinline__ void xcd_barrier_complete(unsigned* bar, unsigned x, unsigned& nloc, unsigned& nx) {
    const unsigned G = gridDim.x * gridDim.y * gridDim.z;
    unsigned sum, cnt, mine, sp = 0u;
    for (;;) {
        sum = 0u; cnt = 0u; mine = 0u;
#pragma unroll
        for (unsigned j = 0; j < 16; ++j) { const unsigned c = xb_ld(&bar[XB_XCNT(j)]); sum += c; cnt += (c > 0u) ? 1u : 0u; mine = (j == x) ? c : mine; }
        if (sum == G) break;
        __builtin_amdgcn_s_sleep(1);
        if ((++sp & 255u) == 0u) { if (xb_ld(&bar[XB_TMO])) break; if (sp > XB_SPIN_CAP) { atomicAdd(&bar[XB_TMO], 1u); break; } }
    }
    nloc = mine > 0u ? mine : 1u; nx = cnt > 0u ? cnt : 1u;
}

__device__ __forceinline__ void xcd_barrier(const XcdBarrier& b) {
    asm volatile("s_waitcnt vmcnt(0)" ::: "memory");
    __syncthreads();
    if (threadIdx.x == 0) {
        unsigned* bar = b.bar;
        __builtin_amdgcn_s_waitcnt(0);
        unsigned nloc = b.st[0], nx = b.st[1];
        if (nloc == 0u) { xcd_barrier_complete(bar, b.x, nloc, nx); b.st[0] = nloc; b.st[1] = nx; }
        const unsigned old = xb_add(&bar[XB_XSUB(b.x)], 1u);
        const unsigned gen = old / nloc;
        if (old + 1u == (gen + 1u) * nloc) {
            __builtin_amdgcn_fence(__ATOMIC_RELEASE, "agent");
            asm volatile("s_waitcnt vmcnt(0)" ::: "memory");
            const unsigned og = xb_add(&bar[XB_TOP], 1u);
            const unsigned tg = og / nx;
            if (og + 1u == (tg + 1u) * nx) xb_add(&bar[XB_TOPGEN], 1u);
            else XB_SPIN(xb_ld(&bar[XB_TOPGEN]) == tg, bar);
            __builtin_amdgcn_fence(__ATOMIC_ACQUIRE, "agent");
            xb_add(&bar[XB_XGEN(b.x)], 1u);
            asm volatile("s_waitcnt vmcnt(0)" ::: "memory");
        } else {
            XB_SPIN(xb_ld(&bar[XB_XGEN(b.x)]) == gen, bar);
            __builtin_amdgcn_fence(__ATOMIC_ACQUIRE, "agent");
            asm volatile("s_waitcnt vmcnt(0)" ::: "memory");
        }
    }
    __syncthreads();
}

struct Frame {
    LAS unsigned char* lds;
    volatile LAS unsigned* MISC;
    gu32* ctl;
    int tid, lane, wave;
    int vcu, G;
};
typedef unsigned u32x2v __attribute__((ext_vector_type(2)));
typedef short s16x4 __attribute__((ext_vector_type(4)));
typedef float f32x16 __attribute__((ext_vector_type(16)));
typedef float f32x2_t __attribute__((ext_vector_type(2)));
typedef __bf16 bf16x2_t __attribute__((ext_vector_type(2)));
__device__ __forceinline__ unsigned cvtpk_s(float lo, float hi) { f32x2_t v = {lo, hi}; bf16x2_t b = __builtin_convertvector(v, bf16x2_t); return __builtin_bit_cast(unsigned, b); }
__device__ __forceinline__ float bflo(unsigned w) { return __uint_as_float(w << 16); }
__device__ __forceinline__ float bfhi(unsigned w) { return __uint_as_float(w & 0xffff0000u); }
__device__ __forceinline__ float sigm_f(float x) { return __builtin_amdgcn_rcpf(1.0f + __builtin_amdgcn_exp2f(-x * LOG2E)); }
__device__ __forceinline__ float silu_f(float x) { return x * sigm_f(x); }
#define MFMA16(a, b, c) __builtin_amdgcn_mfma_f32_16x16x32_bf16((a), (b), (c), 0, 0, 0)
#define MFMA32(a, b, c) __builtin_amdgcn_mfma_f32_32x32x16_bf16((a), (b), (c), 0, 0, 0)

__device__ __forceinline__ float wave_sum(float v) {
#pragma unroll
    for (int o = 1; o < 64; o <<= 1) v += __shfl_xor(v, o);
    return v;
}
template <int MODE> __device__ __forceinline__ int src_col(int R) {
    if (MODE == 0) return R;
    if (MODE == 1) { const int pn = R >> 8, w = R & 255; return (w >> 7) * FF + 128 * pn + (w & 127); }
    if (R < 2560) return R;
    if (R < 5632) return R + 16;
    if (R < 5648) return 2560 + (R - 5632);
    if (R < 5888) return -1;
    return 5648 + (R - 5888);
}
template <int MODE> __device__ __forceinline__ void p0_item(const float* W, int K, int Nsrc, bf16* WT, int nblk, LAS float* scr, int item, int lane) {
    const int kb = item / nblk, nb = item - kb * nblk, k0 = 64 * kb, n0 = 32 * nb;
    const int sc = src_col<MODE>(n0 + (lane & 31));
#pragma unroll 8
    for (int i = 0; i < 32; ++i) { const int kk = 2 * i + (lane >> 5); scr[kk * 33 + (lane & 31)] = (sc >= 0) ? W[(size_t)(k0 + kk) * Nsrc + sc] : 0.f; }
    LDS_WAIT(); asm volatile("" ::: "memory");
    const int c = lane & 7;
#pragma unroll
    for (int j = 0; j < 4; ++j) { const int n = (lane >> 3) + 8 * j; const LAS float* s = scr + (8 * c) * 33 + n;
        v4u o; o.x = pk2(s[0 * 33], s[1 * 33]); o.y = pk2(s[2 * 33], s[3 * 33]); o.z = pk2(s[4 * 33], s[5 * 33]); o.w = pk2(s[6 * 33], s[7 * 33]);
        *(GAS v4u*)(WT + (size_t)(n0 + n) * K + k0 + 8 * c) = o; }
    LDS_WAIT(); asm volatile("" ::: "memory");
}
__device__ __forceinline__ void rms_row_to_bf16(int lane, const float* xrow, const float* w, bf16* orow) {
    const GAS f32x4* xr = (const GAS f32x4*)xrow + lane; const GAS f32x4* wr = (const GAS f32x4*)w + lane;
    f32x4 v[4]; float s = 0.f;
#pragma unroll
    for (int j = 0; j < 4; ++j) { v[j] = xr[64 * j]; s += (v[j].x * v[j].x + v[j].y * v[j].y) + (v[j].z * v[j].z + v[j].w * v[j].w); }
    const float rs = 1.0f / sqrtf(wave_sum(s) * (1.f / DM) + RMS_EPS);
    GAS unsigned long long* o8 = (GAS unsigned long long*)orow + lane;
#pragma unroll
    for (int j = 0; j < 4; ++j) { const f32x4 wv = wr[64 * j];
        o8[64 * j] = (unsigned long long)pk2(v[j].x * rs * wv.x, v[j].y * rs * wv.y) | ((unsigned long long)pk2(v[j].z * rs * wv.z, v[j].w * rs * wv.w) << 32); }
}
__device__ __forceinline__ void rms_row_f32_inplace(int lane, float* xrow, const float* w) {
    GAS f32x4* xr = (GAS f32x4*)xrow + lane; const GAS f32x4* wr = (const GAS f32x4*)w + lane;
    f32x4 v[4]; float s = 0.f;
#pragma unroll
    for (int j = 0; j < 4; ++j) { v[j] = xr[64 * j]; s += (v[j].x * v[j].x + v[j].y * v[j].y) + (v[j].z * v[j].z + v[j].w * v[j].w); }
    const float rs = 1.0f / sqrtf(wave_sum(s) * (1.f / DM) + RMS_EPS);
#pragma unroll
    for (int j = 0; j < 4; ++j) { const f32x4 wv = wr[64 * j]; xr[64 * j] = (v[j] * rs) * wv; }
}
__device__ __forceinline__ void norm_pass(Frame& F, const float* src, const float* w, bf16* dst) {
    const int gw = F.vcu * NWAVES + F.wave, NGW = F.G * NWAVES;
    for (int m = gw; m < TOK; m += NGW) rms_row_to_bf16(F.lane, src + (size_t)m * DM, w, dst + (size_t)m * DM);
}
struct P0Args { const float *x, *nw, *wgu1, *wd1, *win, *wbs, *wba, *wout, *wgu2, *wd2; bf16 *Wgu1, *Wd1, *Win, *Wbs, *Wba, *Wout, *Wgu2, *Wd2, *XN; };
__device__ __forceinline__ void p0_prologue(Frame& F, const P0Args& a) {
    LAS float* scr = (LAS float*)(F.lds + RING_OFF + F.wave * 16384);
    const int gw = F.vcu * NWAVES + F.wave, NGW = F.G * NWAVES;
    constexpr int I_GU = (DM / 64) * (2 * FF / 32), I_D = (FF / 64) * (DM / 32), I_IN = (DM / 64) * (7936 / 32), I_SQ = (DM / 64) * (DM / 32);
    constexpr int NITEMS = 2 * I_GU + 2 * I_D + I_IN + 3 * I_SQ;
    for (int it = gw; it < NITEMS; it += NGW) {
        int r = it;
        if (r < I_GU) { p0_item<1>(a.wgu1, DM, 2 * FF, a.Wgu1, 2 * FF / 32, scr, r, F.lane); continue; } r -= I_GU;
        if (r < I_GU) { p0_item<1>(a.wgu2, DM, 2 * FF, a.Wgu2, 2 * FF / 32, scr, r, F.lane); continue; } r -= I_GU;
        if (r < I_D) { p0_item<0>(a.wd1, FF, DM, a.Wd1, DM / 32, scr, r, F.lane); continue; } r -= I_D;
        if (r < I_D) { p0_item<0>(a.wd2, FF, DM, a.Wd2, DM / 32, scr, r, F.lane); continue; } r -= I_D;
        if (r < I_IN) { p0_item<2>(a.win, DM, 7696, a.Win, 7936 / 32, scr, r, F.lane); continue; } r -= I_IN;
        if (r < I_SQ) { p0_item<0>(a.wbs, DM, DM, a.Wbs, DM / 32, scr, r, F.lane); continue; } r -= I_SQ;
        if (r < I_SQ) { p0_item<0>(a.wba, DM, DM, a.Wba, DM / 32, scr, r, F.lane); continue; } r -= I_SQ;
        p0_item<0>(a.wout, DM, DM, a.Wout, DM / 32, scr, r, F.lane);
    }
    norm_pass(F, a.x, a.nw, a.XN);
}
__device__ __forceinline__ void conv_pass(Frame& F, bf16* XBC, const bf16* HALO, const float* conv_w, const float* conv_b) {
    constexpr int NIT = NCHUNK * 192;
    for (int item = F.vcu * 512 + F.tid; item < NIT; item += F.G * 512) {
        const int chunk = item / 192, ch0 = (item - chunk * 192) * 8;
        float w0[8], w1[8], w2[8], w3[8], bb[8], r0[8], r1[8], r2[8];
#pragma unroll
        for (int e = 0; e < 8; ++e) { w0[e] = conv_w[0 * XBCW + ch0 + e]; w1[e] = conv_w[1 * XBCW + ch0 + e]; w2[e] = conv_w[2 * XBCW + ch0 + e]; w3[e] = conv_w[3 * XBCW + ch0 + e]; bb[e] = conv_b[ch0 + e]; }
        if ((chunk & 127) == 0) {
#pragma unroll
            for (int e = 0; e < 8; ++e) { r0[e] = 0.f; r1[e] = 0.f; r2[e] = 0.f; }
        } else {
            const v4u h0 = *(const GAS v4u*)(HALO + (size_t)(chunk * 3 + 0) * XBCW + ch0), h1 = *(const GAS v4u*)(HALO + (size_t)(chunk * 3 + 1) * XBCW + ch0), h2 = *(const GAS v4u*)(HALO + (size_t)(chunk * 3 + 2) * XBCW + ch0);
            r0[0] = bflo(h0.x); r0[1] = bfhi(h0.x); r0[2] = bflo(h0.y); r0[3] = bfhi(h0.y); r0[4] = bflo(h0.z); r0[5] = bfhi(h0.z); r0[6] = bflo(h0.w); r0[7] = bfhi(h0.w);
            r1[0] = bflo(h1.x); r1[1] = bfhi(h1.x); r1[2] = bflo(h1.y); r1[3] = bfhi(h1.y); r1[4] = bflo(h1.z); r1[5] = bfhi(h1.z); r1[6] = bflo(h1.w); r1[7] = bfhi(h1.w);
            r2[0] = bflo(h2.x); r2[1] = bfhi(h2.x); r2[2] = bflo(h2.y); r2[3] = bfhi(h2.y); r2[4] = bflo(h2.z); r2[5] = bfhi(h2.z); r2[6] = bflo(h2.w); r2[7] = bfhi(h2.w);
        }
        bf16* p = XBC + (size_t)chunk * 64 * XBCW + ch0;
#pragma unroll 4
        for (int t = 0; t < 64; ++t) {
            const v4u raw = *(const GAS v4u*)(p + (size_t)t * XBCW);
            float cur[8]; cur[0] = bflo(raw.x); cur[1] = bfhi(raw.x); cur[2] = bflo(raw.y); cur[3] = bfhi(raw.y); cur[4] = bflo(raw.z); cur[5] = bfhi(raw.z); cur[6] = bflo(raw.w); cur[7] = bfhi(raw.w);
            float y[8];
#pragma unroll
            for (int e = 0; e < 8; ++e) { y[e] = silu_f(bb[e] + w0[e] * r0[e] + w1[e] * r1[e] + w2[e] * r2[e] + w3[e] * cur[e]); r0[e] = r1[e]; r1[e] = r2[e]; r2[e] = cur[e]; }
            v4u o; o.x = cvtpk_s(y[0], y[1]); o.y = cvtpk_s(y[2], y[3]); o.z = cvtpk_s(y[4], y[5]); o.w = cvtpk_s(y[6], y[7]);
            *(GAS v4u*)(p + (size_t)t * XBCW) = o;
        }
    }
}
namespace att {
constexpr int K_OFF = 0, V_OFF = 16384, TBL_OFF = 32768, WSF_OFF = 32768 + 2048;
__device__ __forceinline__ int crow(int r, int hi) { return (r & 3) + 8 * (r >> 2) + 4 * hi; }
typedef short v4i16_t __attribute__((ext_vector_type(4)));
__device__ __forceinline__ s16x4 vtr(const LAS unsigned char* p) { return __builtin_bit_cast(s16x4, __builtin_amdgcn_ds_read_tr16_b64_v4i16((LAS v4i16_t*)p)); }
__device__ __forceinline__ void attn_unit(LAS unsigned char* lds, const bf16* Q, const bf16* K, const bf16* V, bf16* O, const float* rel_bias, int b, int h, int qblk) {
    const int tid = threadIdx.x, lane = tid & 63, r32 = lane & 31, hi = lane >> 5; const int wid = __builtin_amdgcn_readfirstlane(tid >> 6);
    const int wq = wid >> 1, c0 = qblk * 4, cq = c0 + wq;
    const int qo = 32 * (wid & 1) + r32;
    const size_t rowq = (size_t)b * SEQ + (size_t)64 * cq + 32 * (wid & 1);
    LAS float* tbl = (LAS float*)(lds + TBL_OFF);
    LAS float* wsf = (LAS float*)(lds + WSF_OFF) + wid * 64;
    for (int i = tid; i < 257; i += 512) tbl[i] = rel_bias[h * 257 + i] * LOG2E;
    bf16x8 qr[4];
    { const bf16* Qw = Q + (rowq + r32) * DM + h * HD;
#pragma unroll
      for (int d0 = 0; d0 < 4; ++d0) qr[d0] = *(const GAS bf16x8*)(Qw + d0 * 16 + hi * 8); }
    float mrun = -INFINITY, lrun = 0.f; f32x16 o0, o1;
#pragma unroll
    for (int r = 0; r < 16; ++r) { o0[r] = 0.f; o1[r] = 0.f; }
    for (int t = 0; t < 12; ++t) {
        const int ck = c0 - 8 + t; if (ck < 0) continue;
        const size_t krow = (size_t)b * SEQ + (size_t)ck * 64;
        const v4u kv = *(const GAS v4u*)(K + (krow + lane) * DM + h * HD + wid * 8);
        const v4u vv = *(const GAS v4u*)(V + (krow + 16 * (wid & 3) + (lane >> 2)) * DM + h * HD + (wid >> 2) * 32 + (lane & 3) * 8);
        const int buf = (t & 1) * 8192;
        *(LAS v4u*)(lds + K_OFF + buf + wid * 1024 + lane * 16) = kv;
        *(LAS v4u*)(lds + V_OFF + buf + wid * 1024 + lane * 16) = vv;
        __syncthreads();
        const int jd = wq + 8 - t;
        if (jd >= 0 && jd <= 8) {
            const LAS unsigned char* kb = lds + K_OFF + buf + hi * 1024 + r32 * 16;
            f32x16 p0, p1;
#pragma unroll
            for (int r = 0; r < 16; ++r) { p0[r] = 0.f; p1[r] = 0.f; }
#pragma unroll
            for (int d0 = 0; d0 < 4; ++d0) {
                const bf16x8 b0 = *(const LAS bf16x8*)(kb + d0 * 2048), b1 = *(const LAS bf16x8*)(kb + d0 * 2048 + 512);
                p0 = MFMA32(b0, qr[d0], p0); p1 = MFMA32(b1, qr[d0], p1); }
            if (jd >= 3) { const float cb = tbl[256];
#pragma unroll
                for (int r = 0; r < 16; ++r) { p0[r] += cb; p1[r] += cb; }
            } else { const int base = 64 * jd + qo + 128;
#pragma unroll
                for (int r = 0; r < 16; ++r) { const int i0 = base - crow(r, hi), i1 = i0 - 32; p0[r] += tbl[i0 < 256 ? i0 : 256]; p1[r] += tbl[i1 < 256 ? i1 : 256]; }
            }
            float mx = fmaxf(p0[0], p1[0]);
#pragma unroll
            for (int r = 1; r < 16; ++r) mx = fmaxf(mx, fmaxf(p0[r], p1[r]));
            mx = fmaxf(mx, __shfl_xor(mx, 32));
            const float mnew = fmaxf(mrun, mx);
            const float alpha = __builtin_amdgcn_exp2f(mrun - mnew);
            mrun = mnew;
            float ls = 0.f;
#pragma unroll
            for (int r = 0; r < 16; ++r) { p0[r] = __builtin_amdgcn_exp2f(p0[r] - mnew); p1[r] = __builtin_amdgcn_exp2f(p1[r] - mnew); ls += p0[r] + p1[r]; }
            lrun = lrun * alpha + ls;
            if (hi == 0) wsf[r32] = alpha;
            asm volatile("s_waitcnt lgkmcnt(0)" ::: "memory");
#pragma unroll
            for (int r = 0; r < 16; ++r) { const float f = wsf[crow(r, hi)]; o0[r] *= f; o1[r] *= f; }
            v4u w0, w1, w2, w3;
            w0.x = cvtpk_s(p0[0], p0[1]); w0.y = cvtpk_s(p0[2], p0[3]); w0.z = cvtpk_s(p0[4], p0[5]); w0.w = cvtpk_s(p0[6], p0[7]);
            w1.x = cvtpk_s(p0[8], p0[9]); w1.y = cvtpk_s(p0[10], p0[11]); w1.z = cvtpk_s(p0[12], p0[13]); w1.w = cvtpk_s(p0[14], p0[15]);
            w2.x = cvtpk_s(p1[0], p1[1]); w2.y = cvtpk_s(p1[2], p1[3]); w2.z = cvtpk_s(p1[4], p1[5]); w2.w = cvtpk_s(p1[6], p1[7]);
            w3.x = cvtpk_s(p1[8], p1[9]); w3.y = cvtpk_s(p1[10], p1[11]); w3.z = cvtpk_s(p1[12], p1[13]); w3.w = cvtpk_s(p1[14], p1[15]);
            bf16x8 pa[4]; pa[0] = __builtin_bit_cast(bf16x8, w0); pa[1] = __builtin_bit_cast(bf16x8, w1); pa[2] = __builtin_bit_cast(bf16x8, w2); pa[3] = __builtin_bit_cast(bf16x8, w3);
            const LAS unsigned char* vp = lds + V_OFF + buf + ((lane >> 4) & 1) * 32 + (lane & 3) * 8 + (4 * hi + ((lane & 15) >> 2)) * 64;
#pragma unroll
            for (int ks = 0; ks < 4; ++ks) {
                const s16x4 l0 = vtr(vp + ks * 1024), h0 = vtr(vp + ks * 1024 + 512), l1 = vtr(vp + 4096 + ks * 1024), h1 = vtr(vp + 4096 + ks * 1024 + 512);
                const bf16x8 f0 = __builtin_shufflevector(l0, h0, 0, 1, 2, 3, 4, 5, 6, 7), f1 = __builtin_shufflevector(l1, h1, 0, 1, 2, 3, 4, 5, 6, 7);
                o0 = MFMA32(pa[ks], f0, o0); o1 = MFMA32(pa[ks], f1, o1); }
        }
    }
    { const float lt = lrun + __shfl_xor(lrun, 32);
      if (hi == 0) wsf[32 + r32] = 1.0f / lt;
      asm volatile("s_waitcnt lgkmcnt(0)" ::: "memory");
      bf16* Ow = O + rowq * DM + h * HD;
#pragma unroll
      for (int r = 0; r < 16; ++r) { const int q = crow(r, hi); const float f = wsf[32 + q];
          Ow[(size_t)q * DM + r32] = (bf16)f2bf(o0[r] * f); Ow[(size_t)q * DM + 32 + r32] = (bf16)f2bf(o1[r] * f); } }
    __syncthreads();
}
__device__ __forceinline__ void attn_phase(Frame& F, const bf16* Q, const bf16* K, const bf16* V, bf16* O, const float* rel_bias) {
    for (int u = F.vcu; u < NB * NH * (SEQ / 256); u += F.G) {
        const int bh = (u & 255) >> 2, qblk = ((u & 3) << 3) + (u >> 8);
        attn_unit(F.lds + RING_OFF, Q, K, V, O, rel_bias, bh >> 4, bh & 15, qblk);
    }
}
}
namespace ssd {
constexpr int LDT = 72;
constexpr int LDC = 136;
__device__ __forceinline__ void s1_unit(LAS unsigned char* lds, const bf16* XBC, const float* DT, const float* A_log, bf16* ST, int b, int h, int nq) {
    const int tid = threadIdx.x, lane = tid & 63, fr = lane & 15, fq = lane >> 4; const int wid = __builtin_amdgcn_readfirstlane(tid >> 6);
    const int g = h >> 3, nt = wid & 1, pt = wid >> 1;
    const float Ah = -__expf(A_log[h]);
    LAS bf16* BT = (LAS bf16*)lds; LAS bf16* XdT = (LAS bf16*)(lds + 4608); LAS float* scal = (LAS float*)(lds + 13824);
    f32x4 hst = {0.f, 0.f, 0.f, 0.f};
    const int lB = tid >> 2, n8 = (tid & 3) * 8, lX = tid >> 3, p8 = (tid & 7) * 8;
    for (int c = 0; c < 128; ++c) {
        const size_t row0 = (size_t)b * SEQ + (size_t)c * 64;
        v4u bv = {0u, 0u, 0u, 0u}; if (tid < 256) bv = *(const GAS v4u*)(XBC + (row0 + lB) * XBCW + 1024 + g * 128 + nq * 32 + n8);
        const v4u xv = *(const GAS v4u*)(XBC + (row0 + lX) * XBCW + h * 64 + p8);
        if (wid == 0) {
            const float dtv = DT[(row0 + lane) * 16 + h];
            float ac = dtv * Ah;
#pragma unroll
            for (int o = 1; o < 64; o <<= 1) { const float t = __shfl_up(ac, o); if (lane >= o) ac += t; }
            const float tot = __shfl(ac, 63);
            scal[lane] = dtv * __expf(tot - ac);
            if (lane == 0) scal[64] = __expf(tot);
        }
        __syncthreads();
        if (tid < 256) { const unsigned ww[4] = {bv.x, bv.y, bv.z, bv.w};
#pragma unroll
            for (int e = 0; e < 4; ++e) { BT[(n8 + 2 * e) * LDT + lB] = (bf16)(ww[e] & 0xffffu); BT[(n8 + 2 * e + 1) * LDT + lB] = (bf16)(ww[e] >> 16); } }
        { const float sc = scal[lX]; const unsigned ww[4] = {xv.x, xv.y, xv.z, xv.w};
#pragma unroll
          for (int e = 0; e < 4; ++e) { XdT[(p8 + 2 * e) * LDT + lX] = (bf16)f2bf(bflo(ww[e]) * sc); XdT[(p8 + 2 * e + 1) * LDT + lX] = (bf16)f2bf(bfhi(ww[e]) * sc); } }
        const float dec = scal[64];
        __syncthreads();
        { bf16* sp = ST + ((((size_t)b * 128 + c) * 16 + h) * 64 + (16 * pt + fr)) * 128 + 32 * nq + 16 * nt + 4 * fq;
          u32x2v o; o.x = cvtpk_s(hst[0], hst[1]); o.y = cvtpk_s(hst[2], hst[3]); *(GAS u32x2v*)sp = o; }
        f32x4 s = {0.f, 0.f, 0.f, 0.f};
#pragma unroll
        for (int kl = 0; kl < 2; ++kl) {
            const bf16x8 a = *(const LAS bf16x8*)(BT + (16 * nt + fr) * LDT + 32 * kl + 8 * fq), bb = *(const LAS bf16x8*)(XdT + (16 * pt + fr) * LDT + 32 * kl + 8 * fq);
            s = MFMA16(a, bb, s); }
        hst = hst * dec + s;
    }
    __syncthreads();
}
__device__ __forceinline__ void s2_unit(LAS unsigned char* lds, const bf16* XBC, const float* DT, const float* A_log, const float* Dskip, const float* normw, const bf16* ST, bf16* ZY, int b, int c, int g) {
    const int tid = threadIdx.x, lane = tid & 63, fr = lane & 15, fq = lane >> 4; const int wid = __builtin_amdgcn_readfirstlane(tid >> 6);
    const int h = g * 8 + wid;
    const size_t row0 = (size_t)b * SEQ + (size_t)c * 64;
    LAS bf16* Cs = (LAS bf16*)lds; LAS bf16* Bs = (LAS bf16*)(lds + 17408); LAS bf16* XT = (LAS bf16*)(lds + 34816 + wid * 9216);
    LAS float* acs = (LAS float*)(lds + 108544 + wid * 256); LAS float* dtl = (LAS float*)(lds + 110592 + wid * 256); LAS float* ssq = (LAS float*)(lds + 112640);
    const float Ah = -__expf(A_log[h]);
#pragma unroll
    for (int i = 0; i < 2; ++i) { const int idx = tid + 512 * i, l = idx >> 4, n8 = (idx & 15) * 8;
        const v4u cv = *(const GAS v4u*)(XBC + (row0 + l) * XBCW + 1280 + g * 128 + n8), bv = *(const GAS v4u*)(XBC + (row0 + l) * XBCW + 1024 + g * 128 + n8);
        *(LAS v4u*)(Cs + l * LDC + n8) = cv; *(LAS v4u*)(Bs + l * LDC + n8) = bv; }
    { const float dtv = DT[(row0 + lane) * 16 + h];
      float ac = dtv * Ah;
#pragma unroll
      for (int o = 1; o < 64; o <<= 1) { const float t = __shfl_up(ac, o); if (lane >= o) ac += t; }
      acs[lane] = ac; dtl[lane] = dtv; }
    __syncthreads();
#pragma unroll
    for (int i = 0; i < 8; ++i) { const int s = 8 * i + (lane >> 3), p8 = (lane & 7) * 8;
        const v4u xv = *(const GAS v4u*)(XBC + (row0 + s) * XBCW + h * 64 + p8); const float d = dtl[s]; const unsigned ww[4] = {xv.x, xv.y, xv.z, xv.w};
#pragma unroll
        for (int e = 0; e < 4; ++e) { XT[(p8 + 2 * e) * LDT + s] = (bf16)f2bf(bflo(ww[e]) * d); XT[(p8 + 2 * e + 1) * LDT + s] = (bf16)f2bf(bfhi(ww[e]) * d); } }
    __syncthreads();
    f32x4 acc[4][4];
#pragma unroll
    for (int pt = 0; pt < 4; ++pt)
#pragma unroll
        for (int lt = 0; lt < 4; ++lt) acc[pt][lt] = (f32x4){0.f, 0.f, 0.f, 0.f};
    { const bf16* hp = ST + ((((size_t)b * 128 + c) * 16 + h) * 64) * 128;
#pragma unroll
      for (int kn = 0; kn < 4; ++kn) {
          bf16x8 cf[4];
#pragma unroll
          for (int lt = 0; lt < 4; ++lt) cf[lt] = *(const LAS bf16x8*)(Cs + (16 * lt + fr) * LDC + 32 * kn + 8 * fq);
#pragma unroll
          for (int pt = 0; pt < 4; ++pt) { const bf16x8 hf = *(const GAS bf16x8*)(hp + (size_t)(16 * pt + fr) * 128 + 32 * kn + 8 * fq);
#pragma unroll
              for (int lt = 0; lt < 4; ++lt) acc[pt][lt] = MFMA16(hf, cf[lt], acc[pt][lt]); } }
#pragma unroll
      for (int lt = 0; lt < 4; ++lt) { const float ea = __expf(acs[16 * lt + fr]);
#pragma unroll
          for (int pt = 0; pt < 4; ++pt) acc[pt][lt] *= ea; } }
#pragma unroll
    for (int lt = 0; lt < 4; ++lt) { const int l = 16 * lt + fr; const float al = acs[l];
#pragma unroll
        for (int sp = 0; sp < 2; ++sp) { if (2 * sp <= lt) {
            f32x4 cb0 = {0.f, 0.f, 0.f, 0.f}, cb1 = {0.f, 0.f, 0.f, 0.f};
#pragma unroll
            for (int kn = 0; kn < 4; ++kn) { const bf16x8 cfr = *(const LAS bf16x8*)(Cs + (16 * lt + fr) * LDC + 32 * kn + 8 * fq);
                const bf16x8 b0 = *(const LAS bf16x8*)(Bs + (32 * sp + fr) * LDC + 32 * kn + 8 * fq), b1 = *(const LAS bf16x8*)(Bs + (32 * sp + 16 + fr) * LDC + 32 * kn + 8 * fq);
                cb0 = MFMA16(b0, cfr, cb0); cb1 = MFMA16(b1, cfr, cb1); }
            float g0[4], g1[4];
#pragma unroll
            for (int r = 0; r < 4; ++r) { const int s0 = 32 * sp + 4 * fq + r, s1 = s0 + 16;
                const float e0 = __expf(al - acs[s0]), e1 = __expf(al - acs[s1]);
                g0[r] = (s0 <= l) ? cb0[r] * e0 : 0.f; g1[r] = (s1 <= l) ? cb1[r] * e1 : 0.f; }
            v4u gw; gw.x = cvtpk_s(g0[0], g0[1]); gw.y = cvtpk_s(g0[2], g0[3]); gw.z = cvtpk_s(g1[0], g1[1]); gw.w = cvtpk_s(g1[2], g1[3]);
            const bf16x8 gf = __builtin_bit_cast(bf16x8, gw);
#pragma unroll
            for (int pt = 0; pt < 4; ++pt) { const u32x2v lo = *(const LAS u32x2v*)(XT + (16 * pt + fr) * LDT + 32 * sp + 4 * fq), hi2 = *(const LAS u32x2v*)(XT + (16 * pt + fr) * LDT + 32 * sp + 16 + 4 * fq);
                v4u xw; xw.x = lo.x; xw.y = lo.y; xw.z = hi2.x; xw.w = hi2.y;
                acc[pt][lt] = MFMA16(__builtin_bit_cast(bf16x8, xw), gf, acc[pt][lt]); }
        } } }
    const float Dh = Dskip[h];
#pragma unroll
    for (int lt = 0; lt < 4; ++lt) { const int l = 16 * lt + fr; float ss = 0.f;
#pragma unroll
        for (int pt = 0; pt < 4; ++pt) { const int p0 = 16 * pt + 4 * fq;
            const u32x2v xr = *(const GAS u32x2v*)(XBC + (row0 + l) * XBCW + h * 64 + p0), zr = *(const GAS u32x2v*)(ZY + (row0 + l) * DM + h * 64 + p0);
            const float xs[4] = {bflo(xr.x), bfhi(xr.x), bflo(xr.y), bfhi(xr.y)}, zs[4] = {bflo(zr.x), bfhi(zr.x), bflo(zr.y), bfhi(zr.y)};
#pragma unroll
            for (int r = 0; r < 4; ++r) { float y = acc[pt][lt][r] + Dh * xs[r]; y *= silu_f(zs[r]); acc[pt][lt][r] = y; ss += y * y; } }
        ss += __shfl_xor(ss, 16); ss += __shfl_xor(ss, 32);
        if (fq == 0) ssq[wid * 64 + l] = ss; }
    __syncthreads();
#pragma unroll
    for (int lt = 0; lt < 4; ++lt) { const int l = 16 * lt + fr; float tot = 0.f;
#pragma unroll
        for (int w = 0; w < 8; ++w) tot += ssq[w * 64 + l];
        const float rs = 1.0f / sqrtf(tot * (1.f / 512.f) + RMS_EPS);
#pragma unroll
        for (int pt = 0; pt < 4; ++pt) { const int p0 = 16 * pt + 4 * fq; const f32x4 nw = *(const GAS f32x4*)(normw + h * 64 + p0);
            u32x2v o; o.x = cvtpk_s(acc[pt][lt][0] * rs * nw[0], acc[pt][lt][1] * rs * nw[1]); o.y = cvtpk_s(acc[pt][lt][2] * rs * nw[2], acc[pt][lt][3] * rs * nw[3]);
            *(GAS u32x2v*)(ZY + (row0 + l) * DM + h * 64 + p0) = o; } }
    __syncthreads();
}
}

namespace naive {
__device__ __forceinline__ void conv_oop(Frame& F, const bf16* RAW, bf16* DST, const float* conv_w, const float* conv_b) {
    const int NIT = TOK * 192;
    for (int item = F.vcu * 512 + F.tid; item < NIT; item += F.G * 512) {
        const int row = item / 192, ch0 = (item - row * 192) * 8, t = row & (SEQ - 1);
        float y[8];
#pragma unroll
        for (int e = 0; e < 8; ++e) y[e] = conv_b[ch0 + e];
#pragma unroll
        for (int j = 0; j < 4; ++j) { const int tt = t - 3 + j; if (tt >= 0) { const v4u raw = *(const GAS v4u*)(RAW + (size_t)(row - 3 + j) * XBCW + ch0);
            const float c[8] = {bflo(raw.x), bfhi(raw.x), bflo(raw.y), bfhi(raw.y), bflo(raw.z), bfhi(raw.z), bflo(raw.w), bfhi(raw.w)};
#pragma unroll
            for (int e = 0; e < 8; ++e) y[e] += conv_w[j * XBCW + ch0 + e] * c[e]; } }
        v4u o; o.x = cvtpk_s(silu_f(y[0]), silu_f(y[1])); o.y = cvtpk_s(silu_f(y[2]), silu_f(y[3])); o.z = cvtpk_s(silu_f(y[4]), silu_f(y[5])); o.w = cvtpk_s(silu_f(y[6]), silu_f(y[7]));
        *(GAS v4u*)(DST + (size_t)row * XBCW + ch0) = o;
    }
}
__device__ __forceinline__ void ssd_seq(Frame& F, const bf16* XC, const float* DT, const float* A_log, const float* Dskip, const float* normw, bf16* ZY) {
    LAS float* red = (LAS float*)(F.lds + RING_OFF);
    for (int u = F.vcu; u < NB * NGRP; u += F.G) {
        const int b = u >> 1, g = u & 1, h = g * 8 + F.wave, p = F.lane;
        const float Ah = -__expf(A_log[h]), Dh = Dskip[h], nw = normw[h * 64 + p];
        float hs[128];
#pragma unroll
        for (int n = 0; n < 128; ++n) hs[n] = 0.f;
        for (int t = 0; t < SEQ; ++t) {
            const size_t row = (size_t)b * SEQ + t;
            const float dt = DT[row * 16 + h];
            const float dec = __expf(dt * Ah);
            const float xv = bflo((unsigned)XC[row * XBCW + h * 64 + p]);
            const float dx = dt * xv;
            float y = 0.f;
#pragma unroll
            for (int n8 = 0; n8 < 16; ++n8) {
                const v4u bw = *(const GAS v4u*)(XC + row * XBCW + 1024 + g * 128 + n8 * 8), cw = *(const GAS v4u*)(XC + row * XBCW + 1280 + g * 128 + n8 * 8);
                const float bb[8] = {bflo(bw.x), bfhi(bw.x), bflo(bw.y), bfhi(bw.y), bflo(bw.z), bfhi(bw.z), bflo(bw.w), bfhi(bw.w)};
                const float cc[8] = {bflo(cw.x), bfhi(cw.x), bflo(cw.y), bfhi(cw.y), bflo(cw.z), bfhi(cw.z), bflo(cw.w), bfhi(cw.w)};
#pragma unroll
                for (int e = 0; e < 8; ++e) { hs[n8 * 8 + e] = hs[n8 * 8 + e] * dec + dx * bb[e]; y += cc[e] * hs[n8 * 8 + e]; }
            }
            y += Dh * xv;
            const float zv = bflo((unsigned)ZY[row * DM + h * 64 + p]);
            y *= silu_f(zv);
            const float ss = wave_sum(y * y);
            if (F.lane == 0) red[(t & 1) * 8 + F.wave] = ss;
            __syncthreads();
            float tot = 0.f;
#pragma unroll
            for (int w = 0; w < 8; ++w) tot += red[(t & 1) * 8 + w];
            const float rs = 1.0f / sqrtf(tot * (1.f / 512.f) + RMS_EPS);
            ZY[row * DM + h * 64 + p] = (bf16)f2bf(y * rs * nw);
        }
        __syncthreads();
    }
}
__device__ __forceinline__ void attn_seq(Frame& F, const bf16* Q, const bf16* K, const bf16* V, bf16* O, const float* rel_bias) {
    for (int item = F.vcu * 512 + F.tid; item < TOK * NH; item += F.G * 512) {
        const int row = item >> 4, h = item & 15, t = row & (SEQ - 1), b = row >> 13;
        float q[64], acc[64];
#pragma unroll
        for (int d8 = 0; d8 < 8; ++d8) { const v4u w = *(const GAS v4u*)(Q + (size_t)row * DM + h * 64 + d8 * 8);
            q[d8 * 8 + 0] = bflo(w.x); q[d8 * 8 + 1] = bfhi(w.x); q[d8 * 8 + 2] = bflo(w.y); q[d8 * 8 + 3] = bfhi(w.y); q[d8 * 8 + 4] = bflo(w.z); q[d8 * 8 + 5] = bfhi(w.z); q[d8 * 8 + 6] = bflo(w.w); q[d8 * 8 + 7] = bfhi(w.w); }
#pragma unroll
        for (int d = 0; d < 64; ++d) acc[d] = 0.f;
        float m = -INFINITY, l = 0.f;
        const int c = t >> 6; int j0 = (c - 8) * 64; if (j0 < 0) j0 = 0; const int j1 = c * 64 + 64;
        for (int j = j0; j < j1; ++j) {
            const size_t kr = (size_t)b * SEQ + j;
            float s = 0.f;
#pragma unroll
            for (int d8 = 0; d8 < 8; ++d8) { const v4u w = *(const GAS v4u*)(K + kr * DM + h * 64 + d8 * 8);
                s += q[d8 * 8 + 0] * bflo(w.x) + q[d8 * 8 + 1] * bfhi(w.x) + q[d8 * 8 + 2] * bflo(w.y) + q[d8 * 8 + 3] * bfhi(w.y) + q[d8 * 8 + 4] * bflo(w.z) + q[d8 * 8 + 5] * bfhi(w.z) + q[d8 * 8 + 6] * bflo(w.w) + q[d8 * 8 + 7] * bfhi(w.w); }
            int rel = t - j; rel = rel < -128 ? -128 : (rel > 128 ? 128 : rel);
            s += rel_bias[h * 257 + rel + 128] * LOG2E;
            const float mn = fmaxf(m, s), al = __builtin_amdgcn_exp2f(m - mn), pw = __builtin_amdgcn_exp2f(s - mn);
            m = mn; l = l * al + pw;
#pragma unroll
            for (int d8 = 0; d8 < 8; ++d8) { const v4u w = *(const GAS v4u*)(V + kr * DM + h * 64 + d8 * 8);
                acc[d8 * 8 + 0] = acc[d8 * 8 + 0] * al + pw * bflo(w.x); acc[d8 * 8 + 1] = acc[d8 * 8 + 1] * al + pw * bfhi(w.x); acc[d8 * 8 + 2] = acc[d8 * 8 + 2] * al + pw * bflo(w.y); acc[d8 * 8 + 3] = acc[d8 * 8 + 3] * al + pw * bfhi(w.y);
                acc[d8 * 8 + 4] = acc[d8 * 8 + 4] * al + pw * bflo(w.z); acc[d8 * 8 + 5] = acc[d8 * 8 + 5] * al + pw * bfhi(w.z); acc[d8 * 8 + 6] = acc[d8 * 8 + 6] * al + pw * bflo(w.w); acc[d8 * 8 + 7] = acc[d8 * 8 + 7] * al + pw * bfhi(w.w); }
        }
        const float inv = 1.0f / l;
#pragma unroll
        for (int d8 = 0; d8 < 8; ++d8) { v4u o; o.x = cvtpk_s(acc[d8 * 8 + 0] * inv, acc[d8 * 8 + 1] * inv); o.y = cvtpk_s(acc[d8 * 8 + 2] * inv, acc[d8 * 8 + 3] * inv); o.z = cvtpk_s(acc[d8 * 8 + 4] * inv, acc[d8 * 8 + 5] * inv); o.w = cvtpk_s(acc[d8 * 8 + 6] * inv, acc[d8 * 8 + 7] * inv);
            *(GAS v4u*)(O + (size_t)row * DM + h * 64 + d8 * 8) = o; }
    }
}
}

namespace chk {
constexpr int CW_FLAG = 2048;
__device__ __forceinline__ float bfr(float w) { return __uint_as_float(f2bf(w) << 16); }
__device__ __forceinline__ float ldb(const bf16* p) { return __uint_as_float(((unsigned)*p) << 16); }
__device__ __forceinline__ float dotw(const bf16* Arow, const float* W, int N, int col, int K, int lane) {
    float s = 0.f; for (int k = lane; k < K; k += 64) s += ldb(Arow + k) * bfr(W[(size_t)k * N + col]); return wave_sum(s);
}
__device__ __forceinline__ void flag(Frame& F, int bit, bool bad) { if (bad && F.lane == 0) atomicOr((unsigned*)(F.ctl + CW_FLAG), 1u << bit); }
__device__ __forceinline__ bool far(float got, float want, float rel, float abs_) { const float e = fabsf(got - want); return !(e <= rel * fabsf(want) + abs_); }
__device__ __forceinline__ void pick(Frame& F, int N, int salt, int& row, int& col) {
    const unsigned gw = (unsigned)(F.vcu * NWAVES + F.wave); unsigned h = (gw + 1u) * 2654435761u + (unsigned)salt * 40503u; h ^= h >> 15; h *= 2246822519u; h ^= h >> 13;
    row = (int)(h % (unsigned)TOK); col = (int)((h >> 8) % (unsigned)N);
}
__device__ __forceinline__ void c_up(Frame& F, int bit, const bf16* XN, const float* wgu, const bf16* ACT) {
    int row, col; pick(F, FF, bit, row, col);
    const float g = dotw(XN + (size_t)row * DM, wgu, 2 * FF, col, DM, F.lane), u = dotw(XN + (size_t)row * DM, wgu, 2 * FF, FF + col, DM, F.lane);
    flag(F, bit, far(ldb(ACT + (size_t)row * FF + col), silu_f(g) * u, 0.03f, 0.01f));
}
__device__ __forceinline__ void c_down(Frame& F, int bit, const float* base, const bf16* ACT, const float* wd, const float* out) {
    int row, col; pick(F, DM, bit, row, col);
    const float d = dotw(ACT + (size_t)row * FF, wd, DM, col, FF, F.lane);
    flag(F, bit, far(out[(size_t)row * DM + col], base[(size_t)row * DM + col] + 0.5f * d, 0.f, 0.02f));
}
__device__ __forceinline__ void c_norm(Frame& F, int bit, const float* src, const float* w, const bf16* XN) {
    int row, col; pick(F, DM, bit, row, col);
    float s = 0.f; for (int k = F.lane; k < DM; k += 64) { const float v = src[(size_t)row * DM + k]; s += v * v; } s = wave_sum(s);
    const float want = src[(size_t)row * DM + col] / sqrtf(s / DM + RMS_EPS) * w[col];
    flag(F, bit, far(ldb(XN + (size_t)row * DM + col), want, 0.02f, 0.01f));
}
__device__ __forceinline__ void c_in1(Frame& F, int bit, const bf16* XN, const float* win, const bf16* Z, const bf16* XBC, const bf16* Q, const bf16* K, const bf16* V, const float* DT, const float* dt_bias) {
    int row, sc; pick(F, 5648, bit, row, sc);
    const float d = dotw(XN + (size_t)row * DM, win, 7696, sc, DM, F.lane);
    float got, want = d;
    if (sc < 1024) got = ldb(Z + (size_t)row * DM + sc);
    else if (sc < 2560) got = ldb(XBC + (size_t)row * XBCW + (sc - 1024));
    else if (sc < 2576) { got = DT[(size_t)row * 16 + (sc - 2560)]; const float xx = d + dt_bias[sc - 2560]; want = fmaxf(xx, 0.f) + log1pf(__expf(-fabsf(xx))); }
    else if (sc < 3600) { got = ldb(Q + (size_t)row * DM + (sc - 2576)); want = d * QSCALE; }
    else if (sc < 4624) got = ldb(K + (size_t)row * DM + (sc - 3600));
    else got = ldb(V + (size_t)row * DM + (sc - 4624));
    flag(F, bit, far(got, want, 0.03f, 0.02f));
}
__device__ __forceinline__ void c_gate(Frame& F, int bit, const bf16* XN, const float* win, const bf16* G) {
    int row, col; pick(F, NGATE, bit, row, col);
    const float d = dotw(XN + (size_t)row * DM, win, 7696, 5648 + col, DM, F.lane);
    const bool bad = far(ldb(G + (size_t)row * NGATE + col), sigm_f(d), 0.02f, 0.01f);
    flag(F, bit, bad);
}
__device__ __forceinline__ void c_merge(Frame& F, int bit, const bf16* YS, const bf16* YA, const bf16* G, const float* wbs, const float* wba, const bf16* MG) {
    int row, col; pick(F, DM, bit, row, col);
    const float a = dotw(YS + (size_t)row * DM, wbs, DM, col, DM, F.lane), c = dotw(YA + (size_t)row * DM, wba, DM, col, DM, F.lane);
    const float want = ldb(G + (size_t)row * NGATE + col) * a + ldb(G + (size_t)row * NGATE + DM + col) * c;
    flag(F, bit, far(ldb(MG + (size_t)row * DM + col), want, 0.03f, 0.02f));
}
__device__ __forceinline__ void c_wt(Frame& F, const float* win, const bf16* Wt) {
    int k, j; pick(F, NGATE, 77, k, j); k &= (DM - 1);
    unsigned bad = 0;
    for (int kk = F.lane; kk < DM; kk += 64) { const float want = bfr(win[(size_t)kk * 7696 + 5648 + j]); const float got = ldb(Wt + (size_t)(5888 + j) * DM + kk); if (got != want) bad = 1; }
    bad = (unsigned)(__ballot(bad) != 0ull);
    if (bad && F.lane == 0) atomicAdd((unsigned*)(F.ctl + CW_FLAG + 64), 1u);
}
}

struct Args { const float* in[20]; float* out; unsigned char* ws; int ph_lo, ph_hi, li, pad; };
__global__ void __launch_bounds__(NWAVES * 64, 2) fwd_kernel(Args args) {
    extern __shared__ __attribute__((aligned(16))) unsigned char lds[];
    Frame F;
    F.lds = (LAS unsigned char*)lds;
    F.MISC = (volatile LAS unsigned*)(F.lds + MISC_OFF);
    F.tid = threadIdx.x; F.lane = F.tid & 63; F.wave = __builtin_amdgcn_readfirstlane(F.tid >> 6);
    F.G = gridDim.x; { const int bx = blockIdx.x; F.vcu = (F.G % 8 == 0) ? (bx % 8) * (F.G / 8) + bx / 8 : bx; }
    unsigned char* ws = args.ws;
    F.ctl = (gu32*)(ws + WS_CTL);
    for (int u = F.tid; u < (LDS_BYTES - LDSCTL_OFF) / 4; u += NWAVES * 64) ((LAS unsigned*)(F.lds + LDSCTL_OFF))[u] = 0u;
    __syncthreads();
    XcdBarrier bar; bar.bar = (unsigned*)(F.ctl + CW_BAR); bar.x = 0; bar.st = nullptr;
    if (N_LAUNCHES == 1) bar = xcd_barrier_post((unsigned*)(F.ctl + CW_BAR), F.MISC + 8);
#define GRID_BAR() do { if (N_LAUNCHES == 1) xcd_barrier(bar); } while (0)
    const float* x = args.in[0]; float* out = args.out;
    bf16* Wgu1 = (bf16*)(ws + WS_WGU1); bf16* Wd1 = (bf16*)(ws + WS_WD1); bf16* Win = (bf16*)(ws + WS_WIN); bf16* Wbs = (bf16*)(ws + WS_WBS); bf16* Wba = (bf16*)(ws + WS_WBA);
    bf16* Wout = (bf16*)(ws + WS_WOUT); bf16* Wgu2 = (bf16*)(ws + WS_WGU2); bf16* Wd2 = (bf16*)(ws + WS_WD2);
    bf16* XN = (bf16*)(ws + WS_XN); bf16* ZB = (bf16*)(ws + WS_Z); bf16* XBC = (bf16*)(ws + WS_XBC); bf16* QB = (bf16*)(ws + WS_Q); bf16* KB = (bf16*)(ws + WS_K); bf16* VB = (bf16*)(ws + WS_V);
    float* DT = (float*)(ws + WS_DT); bf16* HALO = (bf16*)(ws + WS_HALO); bf16* ACT = (bf16*)(ws + WS_ACT); bf16* ST = (bf16*)(ws + WS_ST); bf16* GB = (bf16*)(ws + WS_G); bf16* MS = (bf16*)(ws + WS_MS);
    const int lo = args.ph_lo, hi = args.ph_hi;
#define IN(k) (lo <= (k) && (k) < hi)
#define SEAM(k) do { if (IN(k) && IN((k) + 1)) GRID_BAR(); } while (0)
    const int bx = (int)blockIdx.x;

    if (IN(0)) { P0Args a{x, args.in[1], args.in[2], args.in[3], args.in[5], args.in[13], args.in[14], args.in[15], args.in[17], args.in[18], Wgu1, Wd1, Win, Wbs, Wba, Wout, Wgu2, Wd2, XN};
        p0_prologue(F, a); }
    SEAM(0);
#if DBG_CHK
    if (IN(1)) chk::c_norm(F, 0, x, args.in[1], XN);
    if (IN(2)) chk::c_up(F, 1, XN, args.in[2], ACT);
    if (IN(3)) chk::c_down(F, 2, x, ACT, args.in[3], out);
    if (IN(4)) chk::c_norm(F, 3, out, args.in[4], XN);
    if (IN(5)) chk::c_in1(F, 4, XN, args.in[5], ZB, XBC, QB, KB, VB, DT, args.in[8]);
    if (IN(9)) { chk::c_gate(F, 5, XN, args.in[5], GB); chk::c_wt(F, args.in[5], Win); }
    if (IN(11)) chk::c_merge(F, 6, ZB, QB, GB, args.in[13], args.in[14], XN);
    if (IN(13)) chk::c_norm(F, 7, out, args.in[16], XN);
    if (IN(14)) chk::c_up(F, 8, XN, args.in[17], ACT);
#endif
    if (IN(1)) { pg8::Gemm g{XN, Wgu1, TOK, 2 * FF, DM}; pg8::StaticOrder S; S.init(TOK, 2 * FF, F.G, bx); pg8::EpiSwiglu E{ACT};
        pg8::gemm_phase<pg8::EpiSwiglu, pg8::StaticOrder, true, true>(F.lds + RING_OFF, g, S, E); }
    SEAM(1);
    if (IN(2)) { pg8::Gemm g{ACT, Wd1, TOK, DM, FF}; pg8::StaticOrder S; S.init(TOK, DM, F.G, bx); pg8::EpiResid E{x, out, 0.5f};
        pg8::gemm_phase<pg8::EpiResid, pg8::StaticOrder, true, true>(F.lds + RING_OFF, g, S, E); }
    SEAM(2);
    if (IN(3)) norm_pass(F, out, args.in[4], XN);
    SEAM(3);
    if (IN(4)) { pg8::Gemm g{XN, Win, TOK, NIN1, DM}; pg8::StaticOrder S; S.init(TOK, NIN1, F.G, bx); pg8::EpiIn1 E{ZB, XBC, QB, KB, VB, HALO, DT, args.in[8]};
        pg8::gemm_phase<pg8::EpiIn1, pg8::StaticOrder, true, true>(F.lds + RING_OFF, g, S, E); }
    SEAM(4);
    if (IN(5)) {
#if !DBG_SSD
        conv_pass(F, XBC, HALO, args.in[6], args.in[7]);
#endif
#if DBG_ATT
        naive::attn_seq(F, QB, KB, VB, QB, args.in[12]);
#else
        att::attn_phase(F, QB, KB, VB, QB, args.in[12]);
#endif
    }
    SEAM(5);
#if DBG_SSD
    if (IN(6)) naive::conv_oop(F, XBC, KB, args.in[6], args.in[7]);
#else
    if (IN(6)) { for (int u = F.vcu; u < NB * NH * 4; u += F.G) ssd::s1_unit(F.lds + RING_OFF, XBC, DT, args.in[9], ST, u >> 6, (u >> 2) & 15, u & 3); }
#endif
    SEAM(6);
#if DBG_SSD
    if (IN(7)) naive::ssd_seq(F, KB, DT, args.in[9], args.in[10], args.in[11], ZB);
#else
    if (IN(7)) { for (int u = F.vcu; u < NB * 128 * NGRP; u += F.G) ssd::s2_unit(F.lds + RING_OFF, XBC, DT, args.in[9], args.in[10], args.in[11], ST, ZB, u >> 8, (u >> 1) & 127, u & 1); }
#endif
    SEAM(7);
    if (IN(8)) { pg8::Gemm g{XN, Win + (size_t)NIN1 * DM, TOK, NGATE, DM}; pg8::StaticOrder S; S.init(TOK, NGATE, F.G, bx); pg8::EpiGate E{GB};
        pg8::gemm_phase<pg8::EpiGate, pg8::StaticOrder, true, true>(F.lds + RING_OFF, g, S, E); }
    SEAM(8);
    if (IN(9)) { pg8::Gemm g{ZB, Wbs, TOK, DM, DM}; pg8::StaticOrder S; S.init(TOK, DM, F.G, bx); pg8::EpiMerge<false> E{GB, nullptr, MS};
        pg8::gemm_phase<pg8::EpiMerge<false>, pg8::StaticOrder, true, true>(F.lds + RING_OFF, g, S, E); }
    if (IN(10)) { pg8::Gemm g{QB, Wba, TOK, DM, DM}; pg8::StaticOrder S; S.init(TOK, DM, F.G, bx); pg8::EpiMerge<true> E{GB + DM, MS, XN};
        pg8::gemm_phase<pg8::EpiMerge<true>, pg8::StaticOrder, true, true>(F.lds + RING_OFF, g, S, E); }
    SEAM(10);
    if (IN(11)) { pg8::Gemm g{XN, Wout, TOK, DM, DM}; pg8::StaticOrder S; S.init(TOK, DM, F.G, bx); pg8::EpiResid E{out, out, 1.0f};
        pg8::gemm_phase<pg8::EpiResid, pg8::StaticOrder, true, true>(F.lds + RING_OFF, g, S, E); }
    SEAM(11);
    if (IN(12)) norm_pass(F, out, args.in[16], XN);
    SEAM(12);
    if (IN(13)) { pg8::Gemm g{XN, Wgu2, TOK, 2 * FF, DM}; pg8::StaticOrder S; S.init(TOK, 2 * FF, F.G, bx); pg8::EpiSwiglu E{ACT};
        pg8::gemm_phase<pg8::EpiSwiglu, pg8::StaticOrder, true, true>(F.lds + RING_OFF, g, S, E); }
    SEAM(13);
    if (IN(14)) { pg8::Gemm g{ACT, Wd2, TOK, DM, FF}; pg8::StaticOrder S; S.init(TOK, DM, F.G, bx); pg8::EpiResid E{out, out, 0.5f};
        pg8::gemm_phase<pg8::EpiResid, pg8::StaticOrder, true, true>(F.lds + RING_OFF, g, S, E); }
    SEAM(14);
    if (IN(15)) { const int gw = F.vcu * NWAVES + F.wave, NGW = F.G * NWAVES; for (int m = gw; m < TOK; m += NGW) rms_row_f32_inplace(F.lane, out + (size_t)m * DM, args.in[19]);
#if DBG_CHK
        { const unsigned fl = __hip_atomic_load(F.ctl + chk::CW_FLAG, RLX_AGENT); const unsigned cnt = __hip_atomic_load(F.ctl + chk::CW_FLAG + 64, RLX_AGENT); const float sc = 1.0f + 0.5f * (float)(cnt ? 32 - __builtin_clz(cnt) : (fl ? __builtin_ctz(fl) + 1 : 0));
          for (int m = gw; m < TOK; m += NGW) { GAS f32x4* xr = (GAS f32x4*)(out + (size_t)m * DM) + F.lane; for (int j = 0; j < 4; ++j) xr[64 * j] = xr[64 * j] * sc; } }
#endif
    }
#undef IN
#undef SEAM
#undef GRID_BAR
}

extern "C" void kernel_launch(void* const* d_in, const int* in_sizes, int n_in, void* d_out, int out_size, void* d_ws, size_t ws_size, hipStream_t stream) {
    static int grid = 0;
    if (grid == 0) {
        if (n_in != 20 || in_sizes[0] != TOK * DM || out_size != TOK * DM || ws_size < WS_END) { fprintf(stderr, "kernel_launch: unexpected shapes (n_in %d, in0 %d, out %d, ws %zu)\n", n_in, n_in > 0 ? in_sizes[0] : -1, out_size, ws_size); grid = -1; return; }
        int dev = 0, cus = 0, per_cu = 0;
        if (hipGetDevice(&dev) != hipSuccess || hipDeviceGetAttribute(&cus, hipDeviceAttributeMultiprocessorCount, dev) != hipSuccess) { grid = -1; return; }
        if (hipFuncSetAttribute((const void*)fwd_kernel, hipFuncAttributeMaxDynamicSharedMemorySize, LDS_BYTES) != hipSuccess) { fprintf(stderr, "kernel_launch: hipFuncSetAttribute failed\n"); grid = -1; return; }
        if (hipOccupancyMaxActiveBlocksPerMultiprocessor(&per_cu, (const void*)fwd_kernel, NWAVES * 64, LDS_BYTES) != hipSuccess || per_cu < 1) { fprintf(stderr, "kernel_launch: occupancy query says %d\n", per_cu); per_cu = 1; }
        (void)hipGetLastError();
        grid = cus;
    }
    if (grid < 0) return;
    if (hipMemsetAsync((char*)d_ws + WS_CTL, 0, CTL_ZERO_BYTES, stream) != hipSuccess) { fprintf(stderr, "kernel_launch: memset failed\n"); return; }
    Args a{};
    for (int i = 0; i < 20; ++i) a.in[i] = (const float*)d_in[i];
    a.out = (float*)d_out; a.ws = (unsigned char*)d_ws;
    if (N_LAUNCHES == 1) {
        a.ph_lo = 0; a.ph_hi = N_PHASES; a.li = 0;
        void* kargs[] = {&a};
        hipError_t e = hipLaunchCooperativeKernel((const void*)fwd_kernel, dim3(grid), dim3(NWAVES * 64), kargs, LDS_BYTES, stream);
        if (e != hipSuccess) fprintf(stderr, "kernel_launch: cooperative launch failed: %s (grid %d)\n", hipGetErrorString(e), grid);
    } else {
        for (int li = 0; li < N_PHASES; ++li) {
            a.ph_lo = li; a.ph_hi = li + 1; a.li = li;
            hipLaunchKernelGGL(fwd_kernel, dim3(grid), dim3(NWAVES * 64), LDS_BYTES, stream, a);
        }
    }
}
```

```cpp
#include <hip/hip_runtime.h>
#include <cstdio>
#include <cstdint>
#define MK_N_LAUNCHES 1
#define DBG_ATT 0
#define DBG_SSD 0
#define DBG_CHK 0
#define PROBE_A 0
#define PROBE_R 0
#define DUP_ATT 0
#define DUP_S2 0
#define DUP_P0 0
constexpr int NB = 4, SEQ = 8192, DM = 1024, NH = 16, HD = 64, FF = 2816, NST = 128, NGRP = 2;
constexpr int TOK = NB * SEQ;
constexpr int XBCW = 1536;
constexpr int NIN1 = 5888;
constexpr int NGATE = 2048;
constexpr int NCHUNK = TOK / 64;
constexpr float RMS_EPS = 1e-6f;
constexpr float LOG2E = 1.4426950408889634f;
constexpr float QSCALE = 0.125f * LOG2E;
namespace pg8 {
#define PG8_LAS __attribute__((address_space(3)))
typedef unsigned short bf16_t;
typedef short bf16x8 __attribute__((ext_vector_type(8)));
typedef float f32x4 __attribute__((ext_vector_type(4)));
typedef unsigned u32x4 __attribute__((ext_vector_type(4)));
constexpr int BM = 256, BK = 64, HALF = 128, HTB = HALF * BK * 2  , STAGE_BYTES = 8 * HTB, NXCD = 8, WGM = 8;

__host__ __device__ __forceinline__ int lds_byte(int r, int c) { const int st = (r >> 4) * 2 + (c >> 5), rr = r & 15, cc = c & 31, ob = rr * 64 + cc * 2; return st * 1024 + (ob ^ (((ob >> 9) & 1) << 5)); }
__host__ __device__ __forceinline__ void stage_rc(int b, int& R, int& C) { const int st = b / 1024, sb = b % 1024, swz = sb ^ (((sb >> 9) & 1) << 5); R = (st >> 1) * 16 + swz / 64; C = (st & 1) * 32 + (swz % 64) / 2; }
__host__ __device__ __forceinline__ int perm32(int rho) { const int n = rho >> 4, i = rho & 15; return 8 * (i >> 2) + 4 * n + (i & 3); }

struct Unit { int pm, pn; };
struct Gemm { const bf16_t* A; const bf16_t* Bt; int M, N, K; };

struct StaticOrder {
    int nM, nN, nwg, G, c;
    __host__ __device__ void init(int M, int N, int G_, int c_) { nM = M / BM; nN = N / BM; nwg = nM * nN; G = G_; c = c_; }
    __host__ __device__ bool next(int i, Unit& u) const {
        const long L = (long)i * G + c; if (L >= nwg) return false;
        int wgid = (int)L; { const int q = nwg / NXCD, r = nwg % NXCD, xcd = wgid % NXCD, off = wgid / NXCD; wgid = (xcd < r ? xcd * (q + 1) : r * (q + 1) + (xcd - r) * q) + off; }
        const int nig = WGM * nN, gid = wgid / nig, fm = gid * WGM, gsz = (nM - fm) < WGM ? (nM - fm) : WGM;
        u.pm = fm + ((wgid % nig) % gsz); u.pn = (wgid % nig) / gsz; return true;
    }
    __device__ __forceinline__ void a_ready(const Unit&) const {}
    __device__ __forceinline__ void done(const Unit&) const {}
};
typedef float f32x2 __attribute__((ext_vector_type(2)));
typedef __bf16 bf16x2v __attribute__((ext_vector_type(2)));
__device__ __forceinline__ unsigned cvt_pk_bf16(float lo, float hi) { f32x2 v = {lo, hi}; bf16x2v b = __builtin_convertvector(v, bf16x2v); return __builtin_bit_cast(unsigned, b); }
__device__ __forceinline__ float sigm(float x) { return __builtin_amdgcn_rcpf(1.0f + __builtin_amdgcn_exp2f(-x * 1.4426950408889634f)); }
__device__ __forceinline__ float silu(float x) { return x * sigm(x); }
__device__ __forceinline__ u32x4 pack8(const f32x4 a, const f32x4 b) { u32x4 w; w.x = cvt_pk_bf16(a[0], a[1]); w.y = cvt_pk_bf16(a[2], a[3]); w.z = cvt_pk_bf16(b[0], b[1]); w.w = cvt_pk_bf16(b[2], b[3]); return w; }
__device__ __forceinline__ float bf_lo(unsigned w) { return __uint_as_float(w << 16); }
__device__ __forceinline__ float bf_hi(unsigned w) { return __uint_as_float(w & 0xffff0000u); }
__device__ __forceinline__ void unpack8(const u32x4 w, f32x4& a, f32x4& b) { a[0] = bf_lo(w.x); a[1] = bf_hi(w.x); a[2] = bf_lo(w.y); a[3] = bf_hi(w.y); b[0] = bf_lo(w.z); b[1] = bf_hi(w.z); b[2] = bf_lo(w.w); b[3] = bf_hi(w.w); }
__device__ __forceinline__ float softplus_f(float x) { return fmaxf(x, 0.f) + log1pf(__expf(-fabsf(x))); }

__device__ __forceinline__ float row_rs(const float* ss, int row) { return ss ? 1.0f / sqrtf(ss[row] * (1.f / DM) + RMS_EPS) : 1.0f; }
struct EpiSwiglu {
    static constexpr bool PERM = true, AFTER_DRAIN = false;
    bf16_t* O; const float* ss;
    __device__ __forceinline__ void operator()(const f32x4 (&acc)[2][2][4][2], const Unit& u, int wr, int wc, int fr, int fq) const {
        const int row0 = u.pm * BM + wr * 64 + fr, col0 = u.pn * 128 + wc * 32 + 8 * fq;
#pragma unroll
        for (int ai = 0; ai < 2; ++ai)
#pragma unroll
            for (int m = 0; m < 4; ++m) { const int row = row0 + ai * HALF + m * 16; bf16_t* rowp = O + (size_t)row * FF + col0; const float rs = row_rs(ss, row);
                f32x4 v0, v1;
#pragma unroll
                for (int j = 0; j < 4; ++j) { v0[j] = silu(acc[ai][0][m][0][j] * rs) * (acc[ai][1][m][0][j] * rs); v1[j] = silu(acc[ai][0][m][1][j] * rs) * (acc[ai][1][m][1][j] * rs); }
                *(u32x4*)rowp = pack8(v0, v1); }
    }
};
struct EpiResidNorm {
    static constexpr bool PERM = true, AFTER_DRAIN = false;
    const float* base; float* out; float scale; bf16_t* XN; const float* w; float* ss;
    __device__ __forceinline__ void operator()(const f32x4 (&acc)[2][2][4][2], const Unit& u, int wr, int wc, int fr, int fq) const {
        const int row0 = u.pm * BM + wr * 64 + fr, col0 = u.pn * BM + wc * 32 + 8 * fq;
        f32x4 wv[2][2];
#pragma unroll
        for (int bj = 0; bj < 2; ++bj)
#pragma unroll
            for (int n = 0; n < 2; ++n) wv[bj][n] = *(const f32x4*)(w + col0 + bj * HALF + 4 * n);
#pragma unroll
        for (int ai = 0; ai < 2; ++ai)
#pragma unroll
            for (int m = 0; m < 4; ++m) { const int row = row0 + ai * HALF + m * 16; const size_t off = (size_t)row * DM + col0; float s = 0.f;
#pragma unroll
                for (int bj = 0; bj < 2; ++bj) { f32x4 v[2];
#pragma unroll
                    for (int n = 0; n < 2; ++n) { const size_t o = off + bj * HALF + 4 * n; v[n] = *(const f32x4*)(base + o) + acc[ai][bj][m][n] * scale; *(f32x4*)(out + o) = v[n];
                        s += (v[n][0] * v[n][0] + v[n][1] * v[n][1]) + (v[n][2] * v[n][2] + v[n][3] * v[n][3]); }
                    *(u32x4*)(XN + off + bj * HALF) = pack8(v[0] * wv[bj][0], v[1] * wv[bj][1]); }
                s += __shfl_xor(s, 16); s += __shfl_xor(s, 32);
                if (fq == 0) atomicAdd(ss + row, s);
                asm volatile("" ::: "memory"); }
    }
};
struct EpiResid {
    static constexpr bool PERM = false, AFTER_DRAIN = false;
    const float* base; float* out; float scale;
    __device__ __forceinline__ void operator()(const f32x4 (&acc)[2][2][4][2], const Unit& u, int wr, int wc, int fr, int fq) const {
        const int row0 = u.pm * BM + wr * 64 + fr, col0 = u.pn * BM + wc * 32 + 4 * fq;
#pragma unroll
        for (int ai = 0; ai < 2; ++ai)
#pragma unroll
            for (int m = 0; m < 4; ++m) { const size_t off = (size_t)(row0 + ai * HALF + m * 16) * DM + col0;
#pragma unroll
                for (int bj = 0; bj < 2; ++bj)
#pragma unroll
                    for (int n = 0; n < 2; ++n) { const size_t o = off + bj * HALF + n * 16; const f32x4 bs = *(const f32x4*)(base + o); *(f32x4*)(out + o) = bs + acc[ai][bj][m][n] * scale; }
                asm volatile("" ::: "memory"); }
    }
};
struct EpiIn1 {
    static constexpr bool PERM = true, AFTER_DRAIN = false;
    bf16_t *Z, *XBC, *Q, *K, *V, *HALO; float* DT; const float* dt_bias; const float* ss;
    __device__ __forceinline__ void operator()(const f32x4 (&acc)[2][2][4][2], const Unit& u, int wr, int wc, int fr, int fq) const {
        const int row0 = u.pm * BM + wr * 64 + fr, pn = u.pn, c8 = wc * 32 + 8 * fq;
        if (pn < 22) {
            bf16_t* base; int ld, colt; float sc = 1.f; bool halo = false;
            if (pn < 4) { base = Z; ld = DM; colt = pn * 256; }
            else if (pn < 10) { base = XBC; ld = XBCW; colt = (pn - 4) * 256; halo = true; }
            else if (pn < 14) { base = Q; ld = DM; colt = (pn - 10) * 256; sc = QSCALE; }
            else if (pn < 18) { base = K; ld = DM; colt = (pn - 14) * 256; }
            else { base = V; ld = DM; colt = (pn - 18) * 256; }
#pragma unroll
            for (int ai = 0; ai < 2; ++ai)
#pragma unroll
                for (int m = 0; m < 4; ++m) { const int row = row0 + ai * HALF + m * 16; const float rsc = row_rs(ss, row) * sc;
#pragma unroll
                    for (int bj = 0; bj < 2; ++bj) { const u32x4 w = pack8(acc[ai][bj][m][0] * rsc, acc[ai][bj][m][1] * rsc); const int col = colt + bj * HALF + c8;
                        *(u32x4*)(base + (size_t)row * ld + col) = w;
                        if (halo && (row & 63) >= 61) *(u32x4*)(HALO + (size_t)(((row >> 6) + 1) * 3 + ((row & 63) - 61)) * XBCW + col) = w; } }
        } else {
            if (wc == 0 && fq < 2) {
#pragma unroll
                for (int ai = 0; ai < 2; ++ai)
#pragma unroll
                    for (int m = 0; m < 4; ++m) { const int row = row0 + ai * HALF + m * 16; const float rs = row_rs(ss, row);
#pragma unroll
                        for (int n = 0; n < 2; ++n) { const int i0 = 8 * fq + 4 * n; const f32x4 bv = *(const f32x4*)(dt_bias + i0); f32x4 o;
#pragma unroll
                            for (int j = 0; j < 4; ++j) o[j] = softplus_f(acc[ai][0][m][n][j] * rs + bv[j]);
                            *(f32x4*)(DT + (size_t)row * 16 + i0) = o; } }
            }
        }
    }
};
struct EpiGate {
    static constexpr bool PERM = true, AFTER_DRAIN = false;
    bf16_t* G; const float* ss;
    __device__ __forceinline__ void operator()(const f32x4 (&acc)[2][2][4][2], const Unit& u, int wr, int wc, int fr, int fq) const {
        const int row0 = u.pm * BM + wr * 64 + fr, col0 = u.pn * BM + wc * 32 + 8 * fq;
#pragma unroll
        for (int ai = 0; ai < 2; ++ai)
#pragma unroll
            for (int m = 0; m < 4; ++m) { const int row = row0 + ai * HALF + m * 16; bf16_t* rowp = G + (size_t)row * NGATE + col0; const float rs = row_rs(ss, row);
#pragma unroll
                for (int bj = 0; bj < 2; ++bj) { f32x4 v0, v1;
#pragma unroll
                    for (int j = 0; j < 4; ++j) { v0[j] = sigm(acc[ai][bj][m][0][j] * rs); v1[j] = sigm(acc[ai][bj][m][1][j] * rs); }
                    *(u32x4*)(rowp + bj * HALF) = pack8(v0, v1); } }
    }
};
template <bool ADD> struct EpiMerge {
    static constexpr bool PERM = true, AFTER_DRAIN = false;
    const bf16_t* G; const bf16_t* MS; bf16_t* O;
    __device__ __forceinline__ void operator()(const f32x4 (&acc)[2][2][4][2], const Unit& u, int wr, int wc, int fr, int fq) const {
        const int row0 = u.pm * BM + wr * 64 + fr, col0 = u.pn * BM + wc * 32 + 8 * fq;
#pragma unroll
        for (int ai = 0; ai < 2; ++ai)
#pragma unroll
            for (int m = 0; m < 4; ++m) { const size_t row = (size_t)(row0 + ai * HALF + m * 16);
#pragma unroll
                for (int bj = 0; bj < 2; ++bj) { const int col = col0 + bj * HALF;
                    f32x4 g0, g1; unpack8(*(const u32x4*)(G + row * NGATE + col), g0, g1);
                    f32x4 v0 = acc[ai][bj][m][0] * g0, v1 = acc[ai][bj][m][1] * g1;
                    if (ADD) { f32x4 m0, m1; unpack8(*(const u32x4*)(MS + row * DM + col), m0, m1); v0 += m0; v1 += m1; }
                    *(u32x4*)(O + row * DM + col) = pack8(v0, v1); } }
    }
};

template <class Epi, class Sched, bool ALIGN_EPI = false, bool SP2 = false>
__device__ __forceinline__ void gemm_phase(PG8_LAS unsigned char* lds, const Gemm g, const Sched& S, const Epi& E) {
    const int tid = threadIdx.x, wid = __builtin_amdgcn_readfirstlane(tid >> 6), lane = tid & 63, wr = wid >> 2, wc = wid & 3, fr = lane & 15, fq = lane >> 4;
    const int K = g.K, nt = K / BK;
    unsigned voffA[2], voffB[2];
#pragma unroll
    for (int i = 0; i < 2; ++i) { int R, C; stage_rc(tid * 16 + i * 8192, R, C); const int Rb = Epi::PERM ? ((R & ~31) + perm32(R & 31)) : R;
        voffA[i] = (unsigned)(R * K + C) * 2u; voffB[i] = (unsigned)(Rb * K + C) * 2u; }
    const size_t kstep = (size_t)(BK * 2);
    const size_t hstep = (size_t)HALF * K * 2;
    const size_t tstep = 2 * hstep;
    const unsigned ldsw = (unsigned)wid * 1024u;
    const int aoff = lds_byte(wr * 64 + fr, fq * 8), boff = lds_byte(wc * 32 + fr, fq * 8);
#define PG8_SA(b, h) (((b) * 2 + (h)) * HTB)
#define PG8_SB(b, h) ((4 + (b) * 2 + (h)) * HTB)
#define PG8_STAGE(bufoff, gbase, voff) do { _Pragma("unroll") for (int _i = 0; _i < 2; ++_i) \
        __builtin_amdgcn_global_load_lds((const unsigned*)((const char*)(gbase) + (voff)[_i]), (PG8_LAS unsigned*)(lds + (bufoff) + ldsw + _i * 8192), 16, 0, 0); } while (0)
#define PG8_LDA(dst, b, h) do { _Pragma("unroll") for (int m = 0; m < 4; ++m) _Pragma("unroll") for (int k = 0; k < 2; ++k) dst[m][k] = *(const PG8_LAS bf16x8*)(lds + PG8_SA(b, h) + aoff + m * 2048 + k * 1024); } while (0)
#define PG8_LDB(dst, b, h) do { _Pragma("unroll") for (int n = 0; n < 2; ++n) _Pragma("unroll") for (int k = 0; k < 2; ++k) dst[n][k] = *(const PG8_LAS bf16x8*)(lds + PG8_SB(b, h) + boff + n * 2048 + k * 1024); } while (0)
#define PG8_MMA(ai, bj, At, Bt) do { __builtin_amdgcn_s_setprio(1); _Pragma("unroll") for (int m = 0; m < 4; ++m) _Pragma("unroll") for (int n = 0; n < 2; ++n) _Pragma("unroll") for (int k = 0; k < 2; ++k) \
        acc[ai][bj][m][n] = __builtin_amdgcn_mfma_f32_16x16x32_bf16(Bt[n][k], At[m][k], acc[ai][bj][m][n], 0, 0, 0); __builtin_amdgcn_s_setprio(0); } while (0)
#define PG8_WAIT_V(n) asm volatile("s_waitcnt vmcnt(" #n ")" ::: "memory")
#define PG8_WAIT_L(n) asm volatile("s_waitcnt lgkmcnt(" #n ")" ::: "memory")
#define PG8_BAR __builtin_amdgcn_s_barrier()
#define PG8_SCHED __builtin_amdgcn_sched_barrier(0)
    Unit cur, nxt; int ui = 0;
    if (!S.next(0, cur)) return;
    f32x4 acc[2][2][4][2];
#pragma unroll
    for (int a = 0; a < 2; ++a)
#pragma unroll
        for (int b = 0; b < 2; ++b)
#pragma unroll
            for (int m = 0; m < 4; ++m)
#pragma unroll
                for (int n = 0; n < 2; ++n) acc[a][b][m][n] = (f32x4){0.f, 0.f, 0.f, 0.f};
    bf16x8 At[4][2], B0[2][2], B1[2][2];
    const char* cA = (const char*)g.A + (size_t)cur.pm * tstep; const char* cB = (const char*)g.Bt + (size_t)cur.pn * tstep;
    S.a_ready(cur);
    if constexpr (SP2) {
        PG8_STAGE(PG8_SB(0, 0), cB, voffB); PG8_STAGE(PG8_SB(0, 1), cB + hstep, voffB); PG8_STAGE(PG8_SA(0, 0), cA, voffA); PG8_STAGE(PG8_SA(0, 1), cA + hstep, voffA);
        if (wr == 1) PG8_BAR;
        PG8_WAIT_V(2); PG8_BAR;
        PG8_STAGE(PG8_SB(1, 0), cB + kstep, voffB); PG8_STAGE(PG8_SA(1, 0), cA + kstep, voffA); PG8_STAGE(PG8_SB(1, 1), cB + hstep + kstep, voffB);
        PG8_WAIT_V(6); PG8_BAR;
    } else {
        PG8_STAGE(PG8_SB(0, 0), cB, voffB); PG8_STAGE(PG8_SA(0, 0), cA, voffA); PG8_STAGE(PG8_SB(0, 1), cB + hstep, voffB); PG8_STAGE(PG8_SA(0, 1), cA + hstep, voffA);
        if (wr == 1) PG8_BAR;
        PG8_WAIT_V(4); PG8_BAR;
        PG8_STAGE(PG8_SB(1, 0), cB + kstep, voffB); PG8_STAGE(PG8_SA(1, 0), cA + kstep, voffA); PG8_STAGE(PG8_SB(1, 1), cB + hstep + kstep, voffB);
        PG8_WAIT_V(6); PG8_BAR;
    }
    for (;;) {
        const bool has_next = S.next(ui + 1, nxt);
        const char* nA = has_next ? (const char*)g.A + (size_t)nxt.pm * tstep : cA; const char* nB = has_next ? (const char*)g.Bt + (size_t)nxt.pn * tstep : cB;
        for (int t = 0; t < nt; t += 2) {
            const bool last = (t == nt - 2);
            const char* a1 = cA + (size_t)(t + 1) * kstep;
            const char* a2 = last ? nA : cA + (size_t)(t + 2) * kstep; const char* b2 = last ? nB : cB + (size_t)(t + 2) * kstep;
            const char* a3 = a2 + kstep; const char* b3 = b2 + kstep;
            if (last && has_next) S.a_ready(nxt);
            if constexpr (SP2) {
            PG8_LDB(B0, 0, 0); PG8_LDB(B1, 0, 1); PG8_SCHED; PG8_LDA(At, 0, 0); PG8_STAGE(PG8_SA(1, 1), a1 + hstep, voffA);
            PG8_WAIT_V(8); PG8_WAIT_L(0); PG8_BAR; PG8_MMA(0, 0, At, B0); PG8_MMA(0, 1, At, B1); PG8_BAR; PG8_SCHED;
            PG8_LDA(At, 0, 1); PG8_STAGE(PG8_SB(0, 0), b2, voffB); PG8_STAGE(PG8_SB(0, 1), b2 + hstep, voffB); PG8_STAGE(PG8_SA(0, 0), a2, voffA);
            PG8_WAIT_V(8); PG8_WAIT_L(0); PG8_BAR; PG8_MMA(1, 0, At, B0); PG8_MMA(1, 1, At, B1); PG8_BAR; PG8_SCHED;
            PG8_LDB(B0, 1, 0); PG8_LDB(B1, 1, 1); PG8_SCHED; PG8_LDA(At, 1, 0); PG8_STAGE(PG8_SA(0, 1), a2 + hstep, voffA);
            PG8_WAIT_V(8); PG8_WAIT_L(0); PG8_BAR; PG8_MMA(0, 0, At, B0); PG8_MMA(0, 1, At, B1); PG8_BAR; PG8_SCHED;
            PG8_LDA(At, 1, 1); PG8_STAGE(PG8_SB(1, 0), b3, voffB); PG8_STAGE(PG8_SB(1, 1), b3 + hstep, voffB); PG8_STAGE(PG8_SA(1, 0), a3, voffA);
            PG8_WAIT_V(8); PG8_WAIT_L(0); PG8_BAR; PG8_MMA(1, 0, At, B0); PG8_MMA(1, 1, At, B1); PG8_BAR; PG8_SCHED;
            } else {
            PG8_LDB(B0, 0, 0); PG8_SCHED; PG8_LDA(At, 0, 0); PG8_STAGE(PG8_SA(1, 1), a1 + hstep, voffA);
            PG8_WAIT_L(8); PG8_BAR; PG8_WAIT_L(0); PG8_MMA(0, 0, At, B0); PG8_BAR; PG8_SCHED;
            PG8_LDB(B1, 0, 1); PG8_STAGE(PG8_SB(0, 0), b2, voffB);
            PG8_BAR; PG8_WAIT_L(0); PG8_MMA(0, 1, At, B1); PG8_BAR;
            PG8_LDA(At, 0, 1); PG8_STAGE(PG8_SA(0, 0), a2, voffA);
            PG8_BAR; PG8_WAIT_L(0); PG8_MMA(1, 0, At, B0); PG8_BAR; PG8_SCHED;
            PG8_STAGE(PG8_SB(0, 1), b2 + hstep, voffB);
            PG8_WAIT_V(6); PG8_BAR; PG8_MMA(1, 1, At, B1); PG8_BAR;
            PG8_LDB(B0, 1, 0); PG8_SCHED; PG8_LDA(At, 1, 0); PG8_STAGE(PG8_SA(0, 1), a2 + hstep, voffA);
            PG8_WAIT_L(8); PG8_BAR; PG8_WAIT_L(0); PG8_MMA(0, 0, At, B0); PG8_BAR; PG8_SCHED;
            PG8_LDB(B1, 1, 1); PG8_STAGE(PG8_SB(1, 0), b3, voffB);
            PG8_BAR; PG8_WAIT_L(0); PG8_MMA(0, 1, At, B1); PG8_BAR;
            PG8_LDA(At, 1, 1); PG8_STAGE(PG8_SA(1, 0), a3, voffA);
            PG8_BAR; PG8_WAIT_L(0); PG8_MMA(1, 0, At, B0); PG8_BAR; PG8_SCHED;
            PG8_STAGE(PG8_SB(1, 1), b3 + hstep, voffB);
            PG8_WAIT_V(6); PG8_BAR; PG8_MMA(1, 1, At, B1); PG8_BAR;
            }
        }
        if constexpr (ALIGN_EPI) { if (wr == 0) PG8_BAR; }
        if constexpr (!Epi::AFTER_DRAIN) { E(acc, cur, wr, wc, fr, fq); S.done(cur); }
        if (!has_next) break;
#pragma unroll
        for (int a = 0; a < 2; ++a)
#pragma unroll
            for (int b = 0; b < 2; ++b)
#pragma unroll
                for (int m = 0; m < 4; ++m)
#pragma unroll
                    for (int n = 0; n < 2; ++n) acc[a][b][m][n] = (f32x4){0.f, 0.f, 0.f, 0.f};
        cur = nxt; cA = nA; cB = nB; ++ui;
        if constexpr (ALIGN_EPI) { if (wr == 1) PG8_BAR; }
    }
    PG8_WAIT_V(0);
    if constexpr (!ALIGN_EPI) { if (wr == 0) PG8_BAR; }
    PG8_BAR;
    if constexpr (Epi::AFTER_DRAIN) { E.fused(acc, cur, wr, wc, fr, fq, lds, wid, lane); S.done(cur); }
#undef PG8_SA
#undef PG8_SB
#undef PG8_STAGE
#undef PG8_LDA
#undef PG8_LDB
#undef PG8_MMA
#undef PG8_WAIT_V
#undef PG8_WAIT_L
#undef PG8_BAR
#undef PG8_SCHED
}
}
constexpr int NWAVES = 8;
#ifndef MK_N_LAUNCHES
#define MK_N_LAUNCHES 1
#endif
constexpr int N_PHASES = 16;
constexpr int N_LAUNCHES = MK_N_LAUNCHES;

constexpr size_t MiB = 1u << 20;
constexpr size_t WS_CTL = 0, CTL_ZERO_BYTES = 1 * MiB;
constexpr size_t WS_WGU1 = 1 * MiB;
constexpr size_t WS_WD1  = 12 * MiB;
constexpr size_t WS_WIN  = 18 * MiB;
constexpr size_t WS_WBS  = 34 * MiB, WS_WBA = 36 * MiB, WS_WOUT = 38 * MiB;
constexpr size_t WS_WGU2 = 40 * MiB, WS_WD2 = 51 * MiB;
constexpr size_t WS_XN   = 57 * MiB;
constexpr size_t WS_Z    = 121 * MiB;
constexpr size_t WS_XBC  = 185 * MiB;
constexpr size_t WS_Q    = 281 * MiB;
constexpr size_t WS_K    = 345 * MiB, WS_V = 409 * MiB;
constexpr size_t WS_DT   = 473 * MiB;
constexpr size_t WS_HALO = 475 * MiB;
constexpr size_t WS_ACT  = 121 * MiB;
constexpr size_t WS_ST   = 345 * MiB;
constexpr size_t WS_G    = 345 * MiB;
constexpr size_t WS_MS   = 185 * MiB;
constexpr size_t WS_END  = 480 * MiB;
constexpr int CW_BAR = 4096;

constexpr int RING_OFF = 0, RING_BYTES = 131072;
constexpr int LDSCTL_OFF = RING_BYTES, MISC_OFF = LDSCTL_OFF + 320;
constexpr int LDS_BYTES = 147456;

#define GAS __attribute__((address_space(1)))
#define LAS __attribute__((address_space(3)))
typedef unsigned short bf16;
typedef unsigned v4u __attribute__((ext_vector_type(4)));
typedef float f32x4 __attribute__((ext_vector_type(4)));
typedef short bf16x8 __attribute__((ext_vector_type(8)));
typedef GAS unsigned gu32;
typedef GAS unsigned long long gu64;
#define RLX_AGENT __ATOMIC_RELAXED, __HIP_MEMORY_SCOPE_AGENT
#define LDS_WAIT() asm volatile("s_waitcnt lgkmcnt(0)" ::: "memory")
#define VM_WAIT() asm volatile("s_waitcnt vmcnt(0)" ::: "memory")
__device__ __forceinline__ unsigned long long rt() { return __builtin_amdgcn_s_memrealtime(); }
__device__ __forceinline__ unsigned f2bf(float f) { unsigned u = __builtin_bit_cast(unsigned, f); return (u + 0x7fffu + ((u >> 16) & 1u)) >> 16; }
__device__ __forceinline__ unsigned pk2(float lo, float hi) { return f2bf(lo) | (f2bf(hi) << 16); }
#define XB_TMO      128
#define XB_XCNT(j)  (256  + 64 * (j))
#define XB_XSUB(j)  (1280 + 64 * (j))
#define XB_XGEN(j)  (2304 + 64 * (j))
#define XB_TOP      3328
#define XB_TOPGEN   3392
#define XCD_BAR_WORDS 3456
#define XB_SPIN_CAP (1u << 22)

__device__ __forceinline__ unsigned xb_ld(unsigned* p)              { return __hip_atomic_load(p, __ATOMIC_RELAXED, __HIP_MEMORY_SCOPE_AGENT); }
__device__ __forceinline__ unsigned xb_add(unsigned* p, unsigned v) { return __hip_atomic_fetch_add(p, v, __ATOMIC_RELAXED, __HIP_MEMORY_SCOPE_AGENT); }
__device__ __forceinline__ unsigned xb_xcc_id() { return (unsigned)__builtin_amdgcn_s_getreg((3 << 11) | 20) & 0xFu; }
#define XB_SPIN(cond, bar) do { unsigned _sp = 0; while (cond) { __builtin_amdgcn_s_sleep(1); \
    if ((++_sp & 255u) == 0u) { if (xb_ld(&(bar)[XB_TMO])) break; if (_sp > XB_SPIN_CAP) { atomicAdd(&(bar)[XB_TMO], 1u); break; } } } } while (0)

struct XcdBarrier {
    unsigned* bar; unsigned x;
    volatile LAS unsigned* st;
};

__device__ __forceinline__ XcdBarrier xcd_barrier_post(unsigned* bar, volatile LAS unsigned* st) {
    XcdBarrier b; b.bar = bar; b.x = xb_xcc_id(); b.st = st;
    if (threadIdx.x == 0) (void)xb_add(&bar[XB_XCNT(b.x)], 1u);
    return b;
}
__device__ __forceinline__ void xcd_barrier_complete(unsigned* bar, unsigned x, unsigned& nloc, unsigned& nx) {
    const unsigned G = gridDim.x * gridDim.y * gridDim.z;
    unsigned sum, cnt, mine, sp = 0u;
    for (;;) {
        sum = 0u; cnt = 0u; mine = 0u;
#pragma unroll
        for (unsigned j = 0; j < 16; ++j) { const unsigned c = xb_ld(&bar[XB_XCNT(j)]); sum += c; cnt += (c > 0u) ? 1u : 0u; mine = (j == x) ? c : mine; }
        if (sum == G) break;
        __builtin_amdgcn_s_sleep(1);
        if ((++sp & 255u) == 0u) { if (xb_ld(&bar[XB_TMO])) break; if (sp > XB_SPIN_CAP) { atomicAdd(&bar[XB_TMO], 1u); break; } }
    }
    nloc = mine > 0u ? mine : 1u; nx = cnt > 0u ? cnt : 1u;
}

__device__ __forceinline__ void xcd_barrier(const XcdBarrier& b) {
    asm volatile("s_waitcnt vmcnt(0)" ::: "memory");
    __syncthreads();
    if (threadIdx.x == 0) {
        unsigned* bar = b.bar;
        __builtin_amdgcn_s_waitcnt(0);
        unsigned nloc = b.st[0], nx = b.st[1];
        if (nloc == 0u) { xcd_barrier_complete(bar, b.x, nloc, nx); b.st[0] = nloc; b.st[1] = nx; }
        const unsigned old = xb_add(&bar[XB_XSUB(b.x)], 1u);
        const unsigned gen = old / nloc;
        if (old + 1u == (gen + 1u) * nloc) {
            __builtin_amdgcn_fence(__ATOMIC_RELEASE, "agent");
            asm volatile("s_waitcnt vmcnt(0)" ::: "memory");
            const unsigned og = xb_add(&bar[XB_TOP], 1u);
            const unsigned tg = og / nx;
            if (og + 1u == (tg + 1u) * nx) xb_add(&bar[XB_TOPGEN], 1u);
            else XB_SPIN(xb_ld(&bar[XB_TOPGEN]) == tg, bar);
            __builtin_amdgcn_fence(__ATOMIC_ACQUIRE, "agent");
            xb_add(&bar[XB_XGEN(b.x)], 1u);
            asm volatile("s_waitcnt vmcnt(0)" ::: "memory");
        } else {
            XB_SPIN(xb_ld(&bar[XB_XGEN(b.x)]) == gen, bar);
            __builtin_amdgcn_fence(__ATOMIC_ACQUIRE, "agent");
            asm volatile("s_waitcnt vmcnt(0)" ::: "memory");
        }
    }
    __syncthreads();
}

struct Frame {
    LAS unsigned char* lds;
    volatile LAS unsigned* MISC;
    gu32* ctl;
    int tid, lane, wave;
    int vcu, G;
};
typedef unsigned u32x2v __attribute__((ext_vector_type(2)));
typedef short s16x4 __attribute__((ext_vector_type(4)));
typedef float f32x16 __attribute__((ext_vector_type(16)));
typedef float f32x2_t __attribute__((ext_vector_type(2)));
typedef __bf16 bf16x2_t __attribute__((ext_vector_type(2)));
__device__ __forceinline__ unsigned cvtpk_s(float lo, float hi) { f32x2_t v = {lo, hi}; bf16x2_t b = __builtin_convertvector(v, bf16x2_t); return __builtin_bit_cast(unsigned, b); }
__device__ __forceinline__ float bflo(unsigned w) { return __uint_as_float(w << 16); }
__device__ __forceinline__ float bfhi(unsigned w) { return __uint_as_float(w & 0xffff0000u); }
__device__ __forceinline__ float sigm_f(float x) { return __builtin_amdgcn_rcpf(1.0f + __builtin_amdgcn_exp2f(-x * LOG2E)); }
__device__ __forceinline__ float silu_f(float x) { return x * sigm_f(x); }
#define MFMA16(a, b, c) __builtin_amdgcn_mfma_f32_16x16x32_bf16((a), (b), (c), 0, 0, 0)
#define MFMA32(a, b, c) __builtin_amdgcn_mfma_f32_32x32x16_bf16((a), (b), (c), 0, 0, 0)

__device__ __forceinline__ float wave_sum(float v) {
#pragma unroll
    for (int o = 1; o < 64; o <<= 1) v += __shfl_xor(v, o);
    return v;
}
template <int MODE> __device__ __forceinline__ int src_col(int R) {
    if (MODE == 0) return R;
    if (MODE == 1) { const int pn = R >> 8, w = R & 255; return (w >> 7) * FF + 128 * pn + (w & 127); }
    if (R < 2560) return R;
    if (R < 5632) return R + 16;
    if (R < 5648) return 2560 + (R - 5632);
    if (R < 5888) return -1;
    return 5648 + (R - 5888);
}
template <int MODE> __device__ __forceinline__ void p0_item(const float* W, int K, int Nsrc, bf16* WT, int nblk, LAS float* scr, int item, int lane) {
    const int kb = item / nblk, nb = item - kb * nblk, k0 = 64 * kb, n0 = 32 * nb;
    const int sc = src_col<MODE>(n0 + (lane & 31));
#pragma unroll 8
    for (int i = 0; i < 32; ++i) { const int kk = 2 * i + (lane >> 5); scr[kk * 33 + (lane & 31)] = (sc >= 0) ? W[(size_t)(k0 + kk) * Nsrc + sc] : 0.f; }
    LDS_WAIT(); asm volatile("" ::: "memory");
    const int c = lane & 7;
#pragma unroll
    for (int j = 0; j < 4; ++j) { const int n = (lane >> 3) + 8 * j; const LAS float* s = scr + (8 * c) * 33 + n;
        v4u o; o.x = pk2(s[0 * 33], s[1 * 33]); o.y = pk2(s[2 * 33], s[3 * 33]); o.z = pk2(s[4 * 33], s[5 * 33]); o.w = pk2(s[6 * 33], s[7 * 33]);
        *(GAS v4u*)(WT + (size_t)(n0 + n) * K + k0 + 8 * c) = o; }
    LDS_WAIT(); asm volatile("" ::: "memory");
}
__device__ __forceinline__ void rms_row_to_bf16(int lane, const float* xrow, const float* w, bf16* orow) {
    const GAS f32x4* xr = (const GAS f32x4*)xrow + lane; const GAS f32x4* wr = (const GAS f32x4*)w + lane;
    f32x4 v[4]; float s = 0.f;
#pragma unroll
    for (int j = 0; j < 4; ++j) { v[j] = xr[64 * j]; s += (v[j].x * v[j].x + v[j].y * v[j].y) + (v[j].z * v[j].z + v[j].w * v[j].w); }
    const float rs = 1.0f / sqrtf(wave_sum(s) * (1.f / DM) + RMS_EPS);
    GAS unsigned long long* o8 = (GAS unsigned long long*)orow + lane;
#pragma unroll
    for (int j = 0; j < 4; ++j) { const f32x4 wv = wr[64 * j];
        o8[64 * j] = (unsigned long long)pk2(v[j].x * rs * wv.x, v[j].y * rs * wv.y) | ((unsigned long long)pk2(v[j].z * rs * wv.z, v[j].w * rs * wv.w) << 32); }
}
__device__ __forceinline__ void rms_row_f32_inplace(int lane, float* xrow, const float* w) {
    GAS f32x4* xr = (GAS f32x4*)xrow + lane; const GAS f32x4* wr = (const GAS f32x4*)w + lane;
    f32x4 v[4]; float s = 0.f;
#pragma unroll
    for (int j = 0; j < 4; ++j) { v[j] = xr[64 * j]; s += (v[j].x * v[j].x + v[j].y * v[j].y) + (v[j].z * v[j].z + v[j].w * v[j].w); }
    const float rs = 1.0f / sqrtf(wave_sum(s) * (1.f / DM) + RMS_EPS);
#pragma unroll
    for (int j = 0; j < 4; ++j) { const f32x4 wv = wr[64 * j]; xr[64 * j] = (v[j] * rs) * wv; }
}
__device__ __forceinline__ void norm_pass(Frame& F, const float* src, const float* w, bf16* dst) {
    const int gw = F.vcu * NWAVES + F.wave, NGW = F.G * NWAVES;
    for (int m = gw; m < TOK; m += NGW) rms_row_to_bf16(F.lane, src + (size_t)m * DM, w, dst + (size_t)m * DM);
}
struct P0Args { const float *x, *nw, *wgu1, *wd1, *win, *wbs, *wba, *wout, *wgu2, *wd2; bf16 *Wgu1, *Wd1, *Win, *Wbs, *Wba, *Wout, *Wgu2, *Wd2, *XN; };
__device__ __forceinline__ void p0_prologue(Frame& F, const P0Args& a) {
    LAS float* scr = (LAS float*)(F.lds + RING_OFF + F.wave * 16384);
    const int gw = F.vcu * NWAVES + F.wave, NGW = F.G * NWAVES;
    constexpr int I_GU = (DM / 64) * (2 * FF / 32), I_D = (FF / 64) * (DM / 32), I_IN = (DM / 64) * (7936 / 32), I_SQ = (DM / 64) * (DM / 32);
    constexpr int NITEMS = 2 * I_GU + 2 * I_D + I_IN + 3 * I_SQ;
    for (int it = gw; it < NITEMS; it += NGW) {
        int r = it;
        if (r < I_GU) { p0_item<1>(a.wgu1, DM, 2 * FF, a.Wgu1, 2 * FF / 32, scr, r, F.lane); continue; } r -= I_GU;
        if (r < I_GU) { p0_item<1>(a.wgu2, DM, 2 * FF, a.Wgu2, 2 * FF / 32, scr, r, F.lane); continue; } r -= I_GU;
        if (r < I_D) { p0_item<0>(a.wd1, FF, DM, a.Wd1, DM / 32, scr, r, F.lane); continue; } r -= I_D;
        if (r < I_D) { p0_item<0>(a.wd2, FF, DM, a.Wd2, DM / 32, scr, r, F.lane); continue; } r -= I_D;
        if (r < I_IN) { p0_item<2>(a.win, DM, 7696, a.Win, 7936 / 32, scr, r, F.lane); continue; } r -= I_IN;
        if (r < I_SQ) { p0_item<0>(a.wbs, DM, DM, a.Wbs, DM / 32, scr, r, F.lane); continue; } r -= I_SQ;
        if (r < I_SQ) { p0_item<0>(a.wba, DM, DM, a.Wba, DM / 32, scr, r, F.lane); continue; } r -= I_SQ;
        p0_item<0>(a.wout, DM, DM, a.Wout, DM / 32, scr, r, F.lane);
    }
    norm_pass(F, a.x, a.nw, a.XN);
}
__device__ __forceinline__ void conv_pass(Frame& F, bf16* XBC, const bf16* HALO, const float* conv_w, const float* conv_b) {
    constexpr int NIT = NCHUNK * 192;
    for (int item = F.vcu * 512 + F.tid; item < NIT; item += F.G * 512) {
        const int chunk = item / 192, ch0 = (item - chunk * 192) * 8;
        float w0[8], w1[8], w2[8], w3[8], bb[8], r0[8], r1[8], r2[8];
#pragma unroll
        for (int e = 0; e < 8; ++e) { w0[e] = conv_w[0 * XBCW + ch0 + e]; w1[e] = conv_w[1 * XBCW + ch0 + e]; w2[e] = conv_w[2 * XBCW + ch0 + e]; w3[e] = conv_w[3 * XBCW + ch0 + e]; bb[e] = conv_b[ch0 + e]; }
        if ((chunk & 127) == 0) {
#pragma unroll
            for (int e = 0; e < 8; ++e) { r0[e] = 0.f; r1[e] = 0.f; r2[e] = 0.f; }
        } else {
            const v4u h0 = *(const GAS v4u*)(HALO + (size_t)(chunk * 3 + 0) * XBCW + ch0), h1 = *(const GAS v4u*)(HALO + (size_t)(chunk * 3 + 1) * XBCW + ch0), h2 = *(const GAS v4u*)(HALO + (size_t)(chunk * 3 + 2) * XBCW + ch0);
            r0[0] = bflo(h0.x); r0[1] = bfhi(h0.x); r0[2] = bflo(h0.y); r0[3] = bfhi(h0.y); r0[4] = bflo(h0.z); r0[5] = bfhi(h0.z); r0[6] = bflo(h0.w); r0[7] = bfhi(h0.w);
            r1[0] = bflo(h1.x); r1[1] = bfhi(h1.x); r1[2] = bflo(h1.y); r1[3] = bfhi(h1.y); r1[4] = bflo(h1.z); r1[5] = bfhi(h1.z); r1[6] = bflo(h1.w); r1[7] = bfhi(h1.w);
            r2[0] = bflo(h2.x); r2[1] = bfhi(h2.x); r2[2] = bflo(h2.y); r2[3] = bfhi(h2.y); r2[4] = bflo(h2.z); r2[5] = bfhi(h2.z); r2[6] = bflo(h2.w); r2[7] = bfhi(h2.w);
        }
        bf16* p = XBC + (size_t)chunk * 64 * XBCW + ch0;
#pragma unroll 4
        for (int t = 0; t < 64; ++t) {
            const v4u raw = *(const GAS v4u*)(p + (size_t)t * XBCW);
            float cur[8]; cur[0] = bflo(raw.x); cur[1] = bfhi(raw.x); cur[2] = bflo(raw.y); cur[3] = bfhi(raw.y); cur[4] = bflo(raw.z); cur[5] = bfhi(raw.z); cur[6] = bflo(raw.w); cur[7] = bfhi(raw.w);
            float y[8];
#pragma unroll
            for (int e = 0; e < 8; ++e) { y[e] = silu_f(bb[e] + w0[e] * r0[e] + w1[e] * r1[e] + w2[e] * r2[e] + w3[e] * cur[e]); r0[e] = r1[e]; r1[e] = r2[e]; r2[e] = cur[e]; }
            v4u o; o.x = cvtpk_s(y[0], y[1]); o.y = cvtpk_s(y[2], y[3]); o.z = cvtpk_s(y[4], y[5]); o.w = cvtpk_s(y[6], y[7]);
            *(GAS v4u*)(p + (size_t)t * XBCW) = o;
        }
    }
}
namespace att {
constexpr int K_OFF = 0, V_OFF = 16384, TBL_OFF = 32768, WSF_OFF = 32768 + 2048;
__device__ __forceinline__ int crow(int r, int hi) { return (r & 3) + 8 * (r >> 2) + 4 * hi; }
typedef short v4i16_t __attribute__((ext_vector_type(4)));
__device__ __forceinline__ s16x4 vtr(const LAS unsigned char* p) { return __builtin_bit_cast(s16x4, __builtin_amdgcn_ds_read_tr16_b64_v4i16((LAS v4i16_t*)p)); }
__device__ __forceinline__ void attn_unit(LAS unsigned char* lds, const bf16* Q, const bf16* K, const bf16* V, bf16* O, const float* rel_bias, int b, int h, int qblk, bool do_store) {
    const int tid = threadIdx.x, lane = tid & 63, r32 = lane & 31, hi = lane >> 5; const int wid = __builtin_amdgcn_readfirstlane(tid >> 6);
    const int wq = wid >> 1, c0 = qblk * 4, cq = c0 + wq;
    const int qo = 32 * (wid & 1) + r32;
    const size_t rowq = (size_t)b * SEQ + (size_t)64 * cq + 32 * (wid & 1);
    LAS float* tbl = (LAS float*)(lds + TBL_OFF);
    LAS float* wsf = (LAS float*)(lds + WSF_OFF) + wid * 64;
    for (int i = tid; i < 257; i += 512) tbl[i] = rel_bias[h * 257 + i] * LOG2E;
    bf16x8 qr[4];
    { const bf16* Qw = Q + (rowq + r32) * DM + h * HD;
#pragma unroll
      for (int d0 = 0; d0 < 4; ++d0) qr[d0] = *(const GAS bf16x8*)(Qw + d0 * 16 + hi * 8); }
    float mrun = -INFINITY, lrun = 0.f; f32x16 o0, o1;
#pragma unroll
    for (int r = 0; r < 16; ++r) { o0[r] = 0.f; o1[r] = 0.f; }
    const int t0 = (c0 >= 8) ? 0 : 8 - c0;
    const bf16* kp = K + ((size_t)b * SEQ + lane) * DM + h * HD + wid * 8;
    const bf16* vp_g = V + ((size_t)b * SEQ + 16 * (wid & 3) + (lane >> 2)) * DM + h * HD + (wid >> 2) * 32 + (lane & 3) * 8;
    v4u kv = *(const GAS v4u*)(kp + (size_t)(c0 - 8 + t0) * 64 * DM), vv = *(const GAS v4u*)(vp_g + (size_t)(c0 - 8 + t0) * 64 * DM);
    __syncthreads();
    for (int t = t0; t < 12; ++t) {
        const int buf = (t & 1) * 8192;
        *(LAS v4u*)(lds + K_OFF + buf + wid * 1024 + lane * 16) = kv;
        *(LAS v4u*)(lds + V_OFF + buf + wid * 1024 + lane * 16) = vv;
        if (t + 1 < 12) { kv = *(const GAS v4u*)(kp + (size_t)(c0 - 7 + t) * 64 * DM); vv = *(const GAS v4u*)(vp_g + (size_t)(c0 - 7 + t) * 64 * DM); }
        asm volatile("s_waitcnt lgkmcnt(0)\n\ts_barrier" ::: "memory");
        const int jd = wq + 8 - t;
        if (jd >= 0 && jd <= 8) {
            const LAS unsigned char* kb = lds + K_OFF + buf + hi * 1024 + r32 * 16;
            f32x16 p0, p1;
#pragma unroll
            for (int r = 0; r < 16; ++r) { p0[r] = 0.f; p1[r] = 0.f; }
#pragma unroll
            for (int d0 = 0; d0 < 4; ++d0) {
                const bf16x8 b0 = *(const LAS bf16x8*)(kb + d0 * 2048), b1 = *(const LAS bf16x8*)(kb + d0 * 2048 + 512);
                p0 = MFMA32(b0, qr[d0], p0); p1 = MFMA32(b1, qr[d0], p1); }
            if (jd >= 3) { const float cb = tbl[256];
#pragma unroll
                for (int r = 0; r < 16; ++r) { p0[r] += cb; p1[r] += cb; }
            } else { const int base = 64 * jd + qo + 128;
#pragma unroll
                for (int r = 0; r < 16; ++r) { const int i0 = base - crow(r, hi), i1 = i0 - 32; p0[r] += tbl[i0 < 256 ? i0 : 256]; p1[r] += tbl[i1 < 256 ? i1 : 256]; }
            }
            float mx = fmaxf(p0[0], p1[0]);
#pragma unroll
            for (int r = 1; r < 16; ++r) mx = fmaxf(mx, fmaxf(p0[r], p1[r]));
            mx = fmaxf(mx, __shfl_xor(mx, 32));
            const float mnew = fmaxf(mrun, mx);
            const float alpha = __builtin_amdgcn_exp2f(mrun - mnew);
            mrun = mnew;
            float ls = 0.f;
#pragma unroll
            for (int r = 0; r < 16; ++r) { p0[r] = __builtin_amdgcn_exp2f(p0[r] - mnew); p1[r] = __builtin_amdgcn_exp2f(p1[r] - mnew); ls += p0[r] + p1[r]; }
            lrun = lrun * alpha + ls;
            if (hi == 0) wsf[r32] = alpha;
            asm volatile("s_waitcnt lgkmcnt(0)" ::: "memory");
#pragma unroll
            for (int r = 0; r < 16; ++r) { const float f = wsf[crow(r, hi)]; o0[r] *= f; o1[r] *= f; }
            v4u w0, w1, w2, w3;
            w0.x = cvtpk_s(p0[0], p0[1]); w0.y = cvtpk_s(p0[2], p0[3]); w0.z = cvtpk_s(p0[4], p0[5]); w0.w = cvtpk_s(p0[6], p0[7]);
            w1.x = cvtpk_s(p0[8], p0[9]); w1.y = cvtpk_s(p0[10], p0[11]); w1.z = cvtpk_s(p0[12], p0[13]); w1.w = cvtpk_s(p0[14], p0[15]);
            w2.x = cvtpk_s(p1[0], p1[1]); w2.y = cvtpk_s(p1[2], p1[3]); w2.z = cvtpk_s(p1[4], p1[5]); w2.w = cvtpk_s(p1[6], p1[7]);
            w3.x = cvtpk_s(p1[8], p1[9]); w3.y = cvtpk_s(p1[10], p1[11]); w3.z = cvtpk_s(p1[12], p1[13]); w3.w = cvtpk_s(p1[14], p1[15]);
            bf16x8 pa[4]; pa[0] = __builtin_bit_cast(bf16x8, w0); pa[1] = __builtin_bit_cast(bf16x8, w1); pa[2] = __builtin_bit_cast(bf16x8, w2); pa[3] = __builtin_bit_cast(bf16x8, w3);
            const LAS unsigned char* vp = lds + V_OFF + buf + ((lane >> 4) & 1) * 32 + (lane & 3) * 8 + (4 * hi + ((lane & 15) >> 2)) * 64;
#pragma unroll
            for (int ks = 0; ks < 4; ++ks) {
                const s16x4 l0 = vtr(vp + ks * 1024), h0 = vtr(vp + ks * 1024 + 512), l1 = vtr(vp + 4096 + ks * 1024), h1 = vtr(vp + 4096 + ks * 1024 + 512);
                const bf16x8 f0 = __builtin_shufflevector(l0, h0, 0, 1, 2, 3, 4, 5, 6, 7), f1 = __builtin_shufflevector(l1, h1, 0, 1, 2, 3, 4, 5, 6, 7);
                o0 = MFMA32(pa[ks], f0, o0); o1 = MFMA32(pa[ks], f1, o1); }
        }
    }
    { const float lt = lrun + __shfl_xor(lrun, 32);
      if (hi == 0) wsf[32 + r32] = 1.0f / lt;
      asm volatile("s_waitcnt lgkmcnt(0)" ::: "memory");
      bf16* Ow = O + rowq * DM + h * HD;
      if (do_store) {
#pragma unroll
      for (int r = 0; r < 16; ++r) { const int q = crow(r, hi); const float f = wsf[32 + q];
          Ow[(size_t)q * DM + r32] = (bf16)f2bf(o0[r] * f); Ow[(size_t)q * DM + 32 + r32] = (bf16)f2bf(o1[r] * f); } } else { asm volatile("" :: "v"(o0), "v"(o1)); } }
    __syncthreads();
}
__device__ __forceinline__ void attn_phase(Frame& F, const bf16* Q, const bf16* K, const bf16* V, bf16* O, const float* rel_bias, bool do_store) {
    for (int u = F.vcu; u < NB * NH * (SEQ / 256); u += F.G) {
        const int bh = (u & 255) >> 2, qblk = ((u & 3) << 3) + (u >> 8);
        attn_unit(F.lds + RING_OFF, Q, K, V, O, rel_bias, bh >> 4, bh & 15, qblk, do_store);
    }
}
}
namespace ssd {
constexpr int LDT = 72;
constexpr int LDC = 136;
typedef short v4i16_t __attribute__((ext_vector_type(4)));
__device__ __forceinline__ s16x4 vtr(const LAS unsigned char* p) { return __builtin_bit_cast(s16x4, __builtin_amdgcn_ds_read_tr16_b64_v4i16((LAS v4i16_t*)p)); }
__device__ __forceinline__ v4u scale8(const v4u x, float sc) { v4u o; o.x = cvtpk_s(bflo(x.x) * sc, bfhi(x.x) * sc); o.y = cvtpk_s(bflo(x.y) * sc, bfhi(x.y) * sc); o.z = cvtpk_s(bflo(x.z) * sc, bfhi(x.z) * sc); o.w = cvtpk_s(bflo(x.w) * sc, bfhi(x.w) * sc); return o; }
constexpr int S1_XROW = 144, S1_BROW = 80, S1_BUF = 64 * S1_XROW + 64 * S1_BROW;
__device__ __forceinline__ void s1_unit(LAS unsigned char* lds, const bf16* XBC, const float* DT, const float* A_log, bf16* ST, int b, int h, int nq) {
    const int tid = threadIdx.x, lane = tid & 63, fr = lane & 15, fq = lane >> 4; const int wid = __builtin_amdgcn_readfirstlane(tid >> 6);
    const int g = h >> 3, nt = wid & 1, pt = wid >> 1;
    const float Ah = -__expf(A_log[h]);
    LAS float* sct = (LAS float*)lds; LAS float* dect = (LAS float*)(lds + 32768);
    LAS unsigned char* img = lds + 33280;
    for (int c = wid; c < 128; c += 8) {
        const float dtv = DT[((size_t)b * SEQ + (size_t)c * 64 + lane) * 16 + h];
        float ac = dtv * Ah;
#pragma unroll
        for (int o = 1; o < 64; o <<= 1) { const float t = __shfl_up(ac, o); if (lane >= o) ac += t; }
        const float tot = __shfl(ac, 63);
        sct[c * 64 + lane] = dtv * __expf(tot - ac);
        if (lane == 0) dect[c] = __expf(tot);
    }
    __syncthreads();
    const int lX = tid >> 3, p8 = (tid & 7) * 8, lB = tid >> 3, n4 = (tid & 7) * 4;
    const bf16* xsrc = XBC + ((size_t)b * SEQ + lX) * XBCW + h * 64 + p8;
    const bf16* bsrc = XBC + ((size_t)b * SEQ + lB) * XBCW + 1024 + g * 128 + nq * 32 + n4;
    const size_t cstep = (size_t)64 * XBCW;
    LAS unsigned char* xw = img + lX * S1_XROW + p8 * 2;
    LAS unsigned char* bw = img + 64 * S1_XROW + lB * S1_BROW + n4 * 2;
    const LAS unsigned char* xtr = img + (8 * fq + (fr >> 2)) * S1_XROW + 32 * pt + (fr & 3) * 8;
    const LAS unsigned char* btr = img + 64 * S1_XROW + (8 * fq + (fr >> 2)) * S1_BROW + 32 * nt + (fr & 3) * 8;
    bf16* sp = ST + (((((size_t)b * 128) * 16 + h) * 4 + nq) * 64 + (16 * pt + fr)) * 32 + 16 * nt + 4 * fq;
    f32x4 hst = {0.f, 0.f, 0.f, 0.f};
    v4u Ax0, Ax1, Bx0, Bx1, Cx0, Cx1, Dx0, Dx1; u32x2v Ab0, Ab1, Bb0, Bb1, Cb0, Cb1, Db0, Db1;
#define S1_LOAD(k, Rx0, Rx1, Rb0, Rb1) do { const size_t o_ = (size_t)(2 * (k)) * cstep; Rx0 = *(const GAS v4u*)(xsrc + o_); Rx1 = *(const GAS v4u*)(xsrc + o_ + cstep); \
        Rb0 = *(const GAS u32x2v*)(bsrc + o_); Rb1 = *(const GAS u32x2v*)(bsrc + o_ + cstep); } while (0)
#define S1_STAGE(k, Rx0, Rx1, Rb0, Rb1) do { const int bo_ = ((k) & 1) * 2 * S1_BUF; const float s0_ = sct[(2 * (k)) * 64 + lX], s1_ = sct[(2 * (k) + 1) * 64 + lX]; \
        *(LAS v4u*)(xw + bo_) = scale8(Rx0, s0_); *(LAS v4u*)(xw + bo_ + S1_BUF) = scale8(Rx1, s1_); *(LAS u32x2v*)(bw + bo_) = Rb0; *(LAS u32x2v*)(bw + bo_ + S1_BUF) = Rb1; } while (0)
#define S1_MM(off, acc) do { _Pragma("unroll") for (int kl = 0; kl < 2; ++kl) { \
        const s16x4 a0 = vtr(btr + (off) + kl * 32 * S1_BROW), a1 = vtr(btr + (off) + kl * 32 * S1_BROW + 4 * S1_BROW), x0 = vtr(xtr + (off) + kl * 32 * S1_XROW), x1 = vtr(xtr + (off) + kl * 32 * S1_XROW + 4 * S1_XROW); \
        const bf16x8 af = __builtin_shufflevector(a0, a1, 0, 1, 2, 3, 4, 5, 6, 7), xf = __builtin_shufflevector(x0, x1, 0, 1, 2, 3, 4, 5, 6, 7); \
        acc = MFMA16(af, xf, acc); } } while (0)
#define S1_COMPUTE(k) do { const int bo_ = ((k) & 1) * 2 * S1_BUF; const float d0_ = dect[2 * (k)], d1_ = dect[2 * (k) + 1]; \
        f32x4 sa_ = {0.f, 0.f, 0.f, 0.f}, sb_ = {0.f, 0.f, 0.f, 0.f}; S1_MM(bo_, sa_); S1_MM(bo_ + S1_BUF, sb_); \
        { u32x2v o2; o2.x = cvtpk_s(hst[0], hst[1]); o2.y = cvtpk_s(hst[2], hst[3]); *(GAS u32x2v*)(sp + (size_t)(2 * (k)) * (16 * 64 * 128)) = o2; } \
        hst = hst * d0_ + sa_; \
        { u32x2v o2; o2.x = cvtpk_s(hst[0], hst[1]); o2.y = cvtpk_s(hst[2], hst[3]); *(GAS u32x2v*)(sp + (size_t)(2 * (k) + 1) * (16 * 64 * 128)) = o2; } \
        hst = hst * d1_ + sb_; } while (0)
#define S1_BAR() asm volatile("s_waitcnt lgkmcnt(0)\n\ts_barrier" ::: "memory")
    S1_LOAD(0, Ax0, Ax1, Ab0, Ab1); S1_LOAD(1, Bx0, Bx1, Bb0, Bb1); S1_LOAD(2, Cx0, Cx1, Cb0, Cb1); S1_LOAD(3, Dx0, Dx1, Db0, Db1);
    S1_STAGE(0, Ax0, Ax1, Ab0, Ab1); S1_LOAD(4, Ax0, Ax1, Ab0, Ab1);
    S1_BAR();
    for (int i = 0; i < 64; i += 4) {
        S1_STAGE(i + 1, Bx0, Bx1, Bb0, Bb1); if (i + 5 < 64) S1_LOAD(i + 5, Bx0, Bx1, Bb0, Bb1);
        S1_COMPUTE(i); S1_BAR();
        S1_STAGE(i + 2, Cx0, Cx1, Cb0, Cb1); if (i + 6 < 64) S1_LOAD(i + 6, Cx0, Cx1, Cb0, Cb1);
        S1_COMPUTE(i + 1); S1_BAR();
        S1_STAGE(i + 3, Dx0, Dx1, Db0, Db1); if (i + 7 < 64) S1_LOAD(i + 7, Dx0, Dx1, Db0, Db1);
        S1_COMPUTE(i + 2); S1_BAR();
        if (i + 4 < 64) { S1_STAGE(i + 4, Ax0, Ax1, Ab0, Ab1); if (i + 8 < 64) S1_LOAD(i + 8, Ax0, Ax1, Ab0, Ab1); }
        S1_COMPUTE(i + 3); S1_BAR();
    }
#undef S1_LOAD
#undef S1_STAGE
#undef S1_MM
#undef S1_COMPUTE
#undef S1_BAR
    __syncthreads();
}
__device__ __forceinline__ void s2_unit(LAS unsigned char* lds, const bf16* XBC, const float* DT, const float* A_log, const float* Dskip, const float* normw, const bf16* ST, bf16* ZY, int b, int c, int g, bool do_store) {
    const int tid = threadIdx.x, lane = tid & 63, fr = lane & 15, fq = lane >> 4; const int wid = __builtin_amdgcn_readfirstlane(tid >> 6);
    const int h = g * 8 + wid;
    const size_t row0 = (size_t)b * SEQ + (size_t)c * 64;
    LAS bf16* Cs = (LAS bf16*)lds; LAS bf16* Bs = (LAS bf16*)(lds + 17408); LAS unsigned char* Xi = lds + 34816 + wid * 9216;
    LAS float* acs = (LAS float*)(lds + 108544 + wid * 256); LAS float* dtl = (LAS float*)(lds + 110592 + wid * 256); LAS float* ssq = (LAS float*)(lds + 112640);
    const float Ah = -__expf(A_log[h]);
    v4u cv[2], bv[2], xv[8]; bf16x8 hf[4][4];
#pragma unroll
    for (int i = 0; i < 2; ++i) { const int idx = tid + 512 * i, l = idx >> 4, n8 = (idx & 15) * 8;
        cv[i] = *(const GAS v4u*)(XBC + (row0 + l) * XBCW + 1280 + g * 128 + n8); bv[i] = *(const GAS v4u*)(XBC + (row0 + l) * XBCW + 1024 + g * 128 + n8); }
    const float dtv = DT[(row0 + lane) * 16 + h];
#pragma unroll
    for (int i = 0; i < 8; ++i) xv[i] = *(const GAS v4u*)(XBC + (row0 + 8 * i + (lane >> 3)) * XBCW + h * 64 + (lane & 7) * 8);
    { const bf16* hp = ST + ((((size_t)b * 128 + c) * 16 + h) * 64) * 128;
#pragma unroll
      for (int kn = 0; kn < 4; ++kn)
#pragma unroll
          for (int pt = 0; pt < 4; ++pt) hf[kn][pt] = *(const GAS bf16x8*)(hp + (size_t)((kn * 64 + 16 * pt + fr) * 32 + 8 * fq)); }
#pragma unroll
    for (int i = 0; i < 2; ++i) { const int idx = tid + 512 * i, l = idx >> 4, n8 = (idx & 15) * 8; *(LAS v4u*)(Cs + l * LDC + n8) = cv[i]; *(LAS v4u*)(Bs + l * LDC + n8) = bv[i]; }
    { float ac = dtv * Ah;
#pragma unroll
      for (int o = 1; o < 64; o <<= 1) { const float t = __shfl_up(ac, o); if (lane >= o) ac += t; }
      acs[lane] = ac; dtl[lane] = dtv; }
#pragma unroll
    for (int i = 0; i < 8; ++i) *(LAS v4u*)(Xi + (8 * i + (lane >> 3)) * 144 + (lane & 7) * 16) = xv[i];
    __syncthreads();
    u32x2v zr[4][4];
#pragma unroll
    for (int lt = 0; lt < 4; ++lt)
#pragma unroll
        for (int pt = 0; pt < 4; ++pt) zr[lt][pt] = *(const GAS u32x2v*)(ZY + (row0 + 16 * lt + fr) * DM + h * 64 + 16 * pt + 4 * fq);
    f32x4 acc[4][4];
#pragma unroll
    for (int pt = 0; pt < 4; ++pt)
#pragma unroll
        for (int lt = 0; lt < 4; ++lt) acc[pt][lt] = (f32x4){0.f, 0.f, 0.f, 0.f};
#pragma unroll
    for (int kn = 0; kn < 4; ++kn) {
        bf16x8 cf[4];
#pragma unroll
        for (int lt = 0; lt < 4; ++lt) cf[lt] = *(const LAS bf16x8*)(Cs + (16 * lt + fr) * LDC + 32 * kn + 8 * fq);
#pragma unroll
        for (int pt = 0; pt < 4; ++pt)
#pragma unroll
            for (int lt = 0; lt < 4; ++lt) acc[pt][lt] = MFMA16(hf[kn][pt], cf[lt], acc[pt][lt]); }
#pragma unroll
    for (int lt = 0; lt < 4; ++lt) { const float ea = __expf(acs[16 * lt + fr]);
#pragma unroll
        for (int pt = 0; pt < 4; ++pt) acc[pt][lt] *= ea; }
    const LAS unsigned char* xtr = Xi + (4 * fq + (fr >> 2)) * 144 + (fr & 3) * 8;
#pragma unroll
    for (int lt = 0; lt < 4; ++lt) { const int l = 16 * lt + fr; const float al = acs[l];
#pragma unroll
        for (int sp = 0; sp < 2; ++sp) { if (2 * sp <= lt) {
            f32x4 cb0 = {0.f, 0.f, 0.f, 0.f}, cb1 = {0.f, 0.f, 0.f, 0.f};
#pragma unroll
            for (int kn = 0; kn < 4; ++kn) { const bf16x8 cfr = *(const LAS bf16x8*)(Cs + (16 * lt + fr) * LDC + 32 * kn + 8 * fq);
                const bf16x8 b0 = *(const LAS bf16x8*)(Bs + (32 * sp + fr) * LDC + 32 * kn + 8 * fq), b1 = *(const LAS bf16x8*)(Bs + (32 * sp + 16 + fr) * LDC + 32 * kn + 8 * fq);
                cb0 = MFMA16(b0, cfr, cb0); cb1 = MFMA16(b1, cfr, cb1); }
            float g0[4], g1[4];
#pragma unroll
            for (int r = 0; r < 4; ++r) { const int s0 = 32 * sp + 4 * fq + r, s1 = s0 + 16;
                const float e0 = __expf(al - acs[s0]) * dtl[s0], e1 = __expf(al - acs[s1]) * dtl[s1];
                g0[r] = (s0 <= l) ? cb0[r] * e0 : 0.f; g1[r] = (s1 <= l) ? cb1[r] * e1 : 0.f; }
            v4u gw; gw.x = cvtpk_s(g0[0], g0[1]); gw.y = cvtpk_s(g0[2], g0[3]); gw.z = cvtpk_s(g1[0], g1[1]); gw.w = cvtpk_s(g1[2], g1[3]);
            const bf16x8 gf = __builtin_bit_cast(bf16x8, gw);
#pragma unroll
            for (int pt = 0; pt < 4; ++pt) { const s16x4 a0 = vtr(xtr + (32 * sp) * 144 + 32 * pt), a1 = vtr(xtr + (32 * sp + 16) * 144 + 32 * pt);
                acc[pt][lt] = MFMA16(__builtin_shufflevector(a0, a1, 0, 1, 2, 3, 4, 5, 6, 7), gf, acc[pt][lt]); }
        } } }
    const float Dh = Dskip[h];
#pragma unroll
    for (int lt = 0; lt < 4; ++lt) { const int l = 16 * lt + fr; float ss = 0.f;
#pragma unroll
        for (int pt = 0; pt < 4; ++pt) { const int p0 = 16 * pt + 4 * fq;
            const u32x2v xr = *(const LAS u32x2v*)(Xi + l * 144 + p0 * 2), zz = zr[lt][pt];
            const float xs[4] = {bflo(xr.x), bfhi(xr.x), bflo(xr.y), bfhi(xr.y)}, zs[4] = {bflo(zz.x), bfhi(zz.x), bflo(zz.y), bfhi(zz.y)};
#pragma unroll
            for (int r = 0; r < 4; ++r) { float y = acc[pt][lt][r] + Dh * xs[r]; y *= silu_f(zs[r]); acc[pt][lt][r] = y; ss += y * y; } }
        ss += __shfl_xor(ss, 16); ss += __shfl_xor(ss, 32);
        if (fq == 0) ssq[wid * 64 + l] = ss; }
    __syncthreads();
#pragma unroll
    for (int lt = 0; lt < 4; ++lt) { const int l = 16 * lt + fr; float tot = 0.f;
#pragma unroll
        for (int w = 0; w < 8; ++w) tot += ssq[w * 64 + l];
        const float rs = 1.0f / sqrtf(tot * (1.f / 512.f) + RMS_EPS);
#pragma unroll
        for (int pt = 0; pt < 4; ++pt) { const int p0 = 16 * pt + 4 * fq; const f32x4 nw = *(const GAS f32x4*)(normw + h * 64 + p0);
            u32x2v o; o.x = cvtpk_s(acc[pt][lt][0] * rs * nw[0], acc[pt][lt][1] * rs * nw[1]); o.y = cvtpk_s(acc[pt][lt][2] * rs * nw[2], acc[pt][lt][3] * rs * nw[3]);
            if (do_store) *(GAS u32x2v*)(ZY + (row0 + l) * DM + h * 64 + p0) = o; else asm volatile("" :: "v"(o)); } }
    __syncthreads();
}
}

namespace naive {
__device__ __forceinline__ void conv_oop(Frame& F, const bf16* RAW, bf16* DST, const float* conv_w, const float* conv_b) {
    const int NIT = TOK * 192;
    for (int item = F.vcu * 512 + F.tid; item < NIT; item += F.G * 512) {
        const int row = item / 192, ch0 = (item - row * 192) * 8, t = row & (SEQ - 1);
        float y[8];
#pragma unroll
        for (int e = 0; e < 8; ++e) y[e] = conv_b[ch0 + e];
#pragma unroll
        for (int j = 0; j < 4; ++j) { const int tt = t - 3 + j; if (tt >= 0) { const v4u raw = *(const GAS v4u*)(RAW + (size_t)(row - 3 + j) * XBCW + ch0);
            const float c[8] = {bflo(raw.x), bfhi(raw.x), bflo(raw.y), bfhi(raw.y), bflo(raw.z), bfhi(raw.z), bflo(raw.w), bfhi(raw.w)};
#pragma unroll
            for (int e = 0; e < 8; ++e) y[e] += conv_w[j * XBCW + ch0 + e] * c[e]; } }
        v4u o; o.x = cvtpk_s(silu_f(y[0]), silu_f(y[1])); o.y = cvtpk_s(silu_f(y[2]), silu_f(y[3])); o.z = cvtpk_s(silu_f(y[4]), silu_f(y[5])); o.w = cvtpk_s(silu_f(y[6]), silu_f(y[7]));
        *(GAS v4u*)(DST + (size_t)row * XBCW + ch0) = o;
    }
}
__device__ __forceinline__ void ssd_seq(Frame& F, const bf16* XC, const float* DT, const float* A_log, const float* Dskip, const float* normw, bf16* ZY) {
    LAS float* red = (LAS float*)(F.lds + RING_OFF);
    for (int u = F.vcu; u < NB * NGRP; u += F.G) {
        const int b = u >> 1, g = u & 1, h = g * 8 + F.wave, p = F.lane;
        const float Ah = -__expf(A_log[h]), Dh = Dskip[h], nw = normw[h * 64 + p];
        float hs[128];
#pragma unroll
        for (int n = 0; n < 128; ++n) hs[n] = 0.f;
        for (int t = 0; t < SEQ; ++t) {
            const size_t row = (size_t)b * SEQ + t;
            const float dt = DT[row * 16 + h];
            const float dec = __expf(dt * Ah);
            const float xv = bflo((unsigned)XC[row * XBCW + h * 64 + p]);
            const float dx = dt * xv;
            float y = 0.f;
#pragma unroll
            for (int n8 = 0; n8 < 16; ++n8) {
                const v4u bw = *(const GAS v4u*)(XC + row * XBCW + 1024 + g * 128 + n8 * 8), cw = *(const GAS v4u*)(XC + row * XBCW + 1280 + g * 128 + n8 * 8);
                const float bb[8] = {bflo(bw.x), bfhi(bw.x), bflo(bw.y), bfhi(bw.y), bflo(bw.z), bfhi(bw.z), bflo(bw.w), bfhi(bw.w)};
                const float cc[8] = {bflo(cw.x), bfhi(cw.x), bflo(cw.y), bfhi(cw.y), bflo(cw.z), bfhi(cw.z), bflo(cw.w), bfhi(cw.w)};
#pragma unroll
                for (int e = 0; e < 8; ++e) { hs[n8 * 8 + e] = hs[n8 * 8 + e] * dec + dx * bb[e]; y += cc[e] * hs[n8 * 8 + e]; }
            }
            y += Dh * xv;
            const float zv = bflo((unsigned)ZY[row * DM + h * 64 + p]);
            y *= silu_f(zv);
            const float ss = wave_sum(y * y);
            if (F.lane == 0) red[(t & 1) * 8 + F.wave] = ss;
            __syncthreads();
            float tot = 0.f;
#pragma unroll
            for (int w = 0; w < 8; ++w) tot += red[(t & 1) * 8 + w];
            const float rs = 1.0f / sqrtf(tot * (1.f / 512.f) + RMS_EPS);
            ZY[row * DM + h * 64 + p] = (bf16)f2bf(y * rs * nw);
        }
        __syncthreads();
    }
}
__device__ __forceinline__ void attn_seq(Frame& F, const bf16* Q, const bf16* K, const bf16* V, bf16* O, const float* rel_bias) {
    for (int item = F.vcu * 512 + F.tid; item < TOK * NH; item += F.G * 512) {
        const int row = item >> 4, h = item & 15, t = row & (SEQ - 1), b = row >> 13;
        float q[64], acc[64];
#pragma unroll
        for (int d8 = 0; d8 < 8; ++d8) { const v4u w = *(const GAS v4u*)(Q + (size_t)row * DM + h * 64 + d8 * 8);
            q[d8 * 8 + 0] = bflo(w.x); q[d8 * 8 + 1] = bfhi(w.x); q[d8 * 8 + 2] = bflo(w.y); q[d8 * 8 + 3] = bfhi(w.y); q[d8 * 8 + 4] = bflo(w.z); q[d8 * 8 + 5] = bfhi(w.z); q[d8 * 8 + 6] = bflo(w.w); q[d8 * 8 + 7] = bfhi(w.w); }
#pragma unroll
        for (int d = 0; d < 64; ++d) acc[d] = 0.f;
        float m = -INFINITY, l = 0.f;
        const int c = t >> 6; int j0 = (c - 8) * 64; if (j0 < 0) j0 = 0; const int j1 = c * 64 + 64;
        for (int j = j0; j < j1; ++j) {
            const size_t kr = (size_t)b * SEQ + j;
            float s = 0.f;
#pragma unroll
            for (int d8 = 0; d8 < 8; ++d8) { const v4u w = *(const GAS v4u*)(K + kr * DM + h * 64 + d8 * 8);
                s += q[d8 * 8 + 0] * bflo(w.x) + q[d8 * 8 + 1] * bfhi(w.x) + q[d8 * 8 + 2] * bflo(w.y) + q[d8 * 8 + 3] * bfhi(w.y) + q[d8 * 8 + 4] * bflo(w.z) + q[d8 * 8 + 5] * bfhi(w.z) + q[d8 * 8 + 6] * bflo(w.w) + q[d8 * 8 + 7] * bfhi(w.w); }
            int rel = t - j; rel = rel < -128 ? -128 : (rel > 128 ? 128 : rel);
            s += rel_bias[h * 257 + rel + 128] * LOG2E;
            const float mn = fmaxf(m, s), al = __builtin_amdgcn_exp2f(m - mn), pw = __builtin_amdgcn_exp2f(s - mn);
            m = mn; l = l * al + pw;
#pragma unroll
            for (int d8 = 0; d8 < 8; ++d8) { const v4u w = *(const GAS v4u*)(V + kr * DM + h * 64 + d8 * 8);
                acc[d8 * 8 + 0] = acc[d8 * 8 + 0] * al + pw * bflo(w.x); acc[d8 * 8 + 1] = acc[d8 * 8 + 1] * al + pw * bfhi(w.x); acc[d8 * 8 + 2] = acc[d8 * 8 + 2] * al + pw * bflo(w.y); acc[d8 * 8 + 3] = acc[d8 * 8 + 3] * al + pw * bfhi(w.y);
                acc[d8 * 8 + 4] = acc[d8 * 8 + 4] * al + pw * bflo(w.z); acc[d8 * 8 + 5] = acc[d8 * 8 + 5] * al + pw * bfhi(w.z); acc[d8 * 8 + 6] = acc[d8 * 8 + 6] * al + pw * bflo(w.w); acc[d8 * 8 + 7] = acc[d8 * 8 + 7] * al + pw * bfhi(w.w); }
        }
        const float inv = 1.0f / l;
#pragma unroll
        for (int d8 = 0; d8 < 8; ++d8) { v4u o; o.x = cvtpk_s(acc[d8 * 8 + 0] * inv, acc[d8 * 8 + 1] * inv); o.y = cvtpk_s(acc[d8 * 8 + 2] * inv, acc[d8 * 8 + 3] * inv); o.z = cvtpk_s(acc[d8 * 8 + 4] * inv, acc[d8 * 8 + 5] * inv); o.w = cvtpk_s(acc[d8 * 8 + 6] * inv, acc[d8 * 8 + 7] * inv);
            *(GAS v4u*)(O + (size_t)row * DM + h * 64 + d8 * 8) = o; }
    }
}
}

namespace chk {
constexpr int CW_FLAG = 2048;
__device__ __forceinline__ float bfr(float w) { return __uint_as_float(f2bf(w) << 16); }
__device__ __forceinline__ float ldb(const bf16* p) { return __uint_as_float(((unsigned)*p) << 16); }
__device__ __forceinline__ float dotw(const bf16* Arow, const float* W, int N, int col, int K, int lane) {
    float s = 0.f; for (int k = lane; k < K; k += 64) s += ldb(Arow + k) * bfr(W[(size_t)k * N + col]); return wave_sum(s);
}
__device__ __forceinline__ void flag(Frame& F, int bit, bool bad) { if (bad && F.lane == 0) atomicOr((unsigned*)(F.ctl + CW_FLAG), 1u << bit); }
__device__ __forceinline__ bool far(float got, float want, float rel, float abs_) { const float e = fabsf(got - want); return !(e <= rel * fabsf(want) + abs_); }
__device__ __forceinline__ void pick(Frame& F, int N, int salt, int& row, int& col) {
    const unsigned gw = (unsigned)(F.vcu * NWAVES + F.wave); unsigned h = (gw + 1u) * 2654435761u + (unsigned)salt * 40503u; h ^= h >> 15; h *= 2246822519u; h ^= h >> 13;
    row = (int)(h % (unsigned)TOK); col = (int)((h >> 8) % (unsigned)N);
}
__device__ __forceinline__ void c_up(Frame& F, int bit, const bf16* XN, const float* wgu, const bf16* ACT) {
    int row, col; pick(F, FF, bit, row, col);
    const float g = dotw(XN + (size_t)row * DM, wgu, 2 * FF, col, DM, F.lane), u = dotw(XN + (size_t)row * DM, wgu, 2 * FF, FF + col, DM, F.lane);
    flag(F, bit, far(ldb(ACT + (size_t)row * FF + col), silu_f(g) * u, 0.03f, 0.01f));
}
__device__ __forceinline__ void c_down(Frame& F, int bit, const float* base, const bf16* ACT, const float* wd, const float* out) {
    int row, col; pick(F, DM, bit, row, col);
    const float d = dotw(ACT + (size_t)row * FF, wd, DM, col, FF, F.lane);
    flag(F, bit, far(out[(size_t)row * DM + col], base[(size_t)row * DM + col] + 0.5f * d, 0.f, 0.02f));
}
__device__ __forceinline__ void c_norm(Frame& F, int bit, const float* src, const float* w, const bf16* XN) {
    int row, col; pick(F, DM, bit, row, col);
    float s = 0.f; for (int k = F.lane; k < DM; k += 64) { const float v = src[(size_t)row * DM + k]; s += v * v; } s = wave_sum(s);
    const float want = src[(size_t)row * DM + col] / sqrtf(s / DM + RMS_EPS) * w[col];
    flag(F, bit, far(ldb(XN + (size_t)row * DM + col), want, 0.02f, 0.01f));
}
__device__ __forceinline__ void c_in1(Frame& F, int bit, const bf16* XN, const float* win, const bf16* Z, const bf16* XBC, const bf16* Q, const bf16* K, const bf16* V, const float* DT, const float* dt_bias) {
    int row, sc; pick(F, 5648, bit, row, sc);
    const float d = dotw(XN + (size_t)row * DM, win, 7696, sc, DM, F.lane);
    float got, want = d;
    if (sc < 1024) got = ldb(Z + (size_t)row * DM + sc);
    else if (sc < 2560) got = ldb(XBC + (size_t)row * XBCW + (sc - 1024));
    else if (sc < 2576) { got = DT[(size_t)row * 16 + (sc - 2560)]; const float xx = d + dt_bias[sc - 2560]; want = fmaxf(xx, 0.f) + log1pf(__expf(-fabsf(xx))); }
    else if (sc < 3600) { got = ldb(Q + (size_t)row * DM + (sc - 2576)); want = d * QSCALE; }
    else if (sc < 4624) got = ldb(K + (size_t)row * DM + (sc - 3600));
    else got = ldb(V + (size_t)row * DM + (sc - 4624));
    flag(F, bit, far(got, want, 0.03f, 0.02f));
}
__device__ __forceinline__ void c_gate(Frame& F, int bit, const bf16* XN, const float* win, const bf16* G) {
    int row, col; pick(F, NGATE, bit, row, col);
    const float d = dotw(XN + (size_t)row * DM, win, 7696, 5648 + col, DM, F.lane);
    const bool bad = far(ldb(G + (size_t)row * NGATE + col), sigm_f(d), 0.02f, 0.01f);
    flag(F, bit, bad);
}
__device__ __forceinline__ void c_merge(Frame& F, int bit, const bf16* YS, const bf16* YA, const bf16* G, const float* wbs, const float* wba, const bf16* MG) {
    int row, col; pick(F, DM, bit, row, col);
    const float a = dotw(YS + (size_t)row * DM, wbs, DM, col, DM, F.lane), c = dotw(YA + (size_t)row * DM, wba, DM, col, DM, F.lane);
    const float want = ldb(G + (size_t)row * NGATE + col) * a + ldb(G + (size_t)row * NGATE + DM + col) * c;
    flag(F, bit, far(ldb(MG + (size_t)row * DM + col), want, 0.03f, 0.02f));
}
__device__ __forceinline__ void c_wt(Frame& F, const float* win, const bf16* Wt) {
    int k, j; pick(F, NGATE, 77, k, j); k &= (DM - 1);
    unsigned bad = 0;
    for (int kk = F.lane; kk < DM; kk += 64) { const float want = bfr(win[(size_t)kk * 7696 + 5648 + j]); const float got = ldb(Wt + (size_t)(5888 + j) * DM + kk); if (got != want) bad = 1; }
    bad = (unsigned)(__ballot(bad) != 0ull);
    if (bad && F.lane == 0) atomicAdd((unsigned*)(F.ctl + CW_FLAG + 64), 1u);
}
}

struct Args { const float* in[20]; float* out; unsigned char* ws; int ph_lo, ph_hi, li, pad; };
__global__ void __launch_bounds__(NWAVES * 64, 2) fwd_kernel(Args args) {
    extern __shared__ __attribute__((aligned(16))) unsigned char lds[];
    Frame F;
    F.lds = (LAS unsigned char*)lds;
    F.MISC = (volatile LAS unsigned*)(F.lds + MISC_OFF);
    F.tid = threadIdx.x; F.lane = F.tid & 63; F.wave = __builtin_amdgcn_readfirstlane(F.tid >> 6);
    F.G = gridDim.x; { const int bx = blockIdx.x; F.vcu = (F.G % 8 == 0) ? (bx % 8) * (F.G / 8) + bx / 8 : bx; }
    unsigned char* ws = args.ws;
    F.ctl = (gu32*)(ws + WS_CTL);
    for (int u = F.tid; u < (LDS_BYTES - LDSCTL_OFF) / 4; u += NWAVES * 64) ((LAS unsigned*)(F.lds + LDSCTL_OFF))[u] = 0u;
    __syncthreads();
    XcdBarrier bar; bar.bar = (unsigned*)(F.ctl + CW_BAR); bar.x = 0; bar.st = nullptr;
    if (N_LAUNCHES == 1) bar = xcd_barrier_post((unsigned*)(F.ctl + CW_BAR), F.MISC + 8);
#define GRID_BAR() do { if (N_LAUNCHES == 1) xcd_barrier(bar); } while (0)
    const float* x = args.in[0]; float* out = args.out;
    bf16* Wgu1 = (bf16*)(ws + WS_WGU1); bf16* Wd1 = (bf16*)(ws + WS_WD1); bf16* Win = (bf16*)(ws + WS_WIN); bf16* Wbs = (bf16*)(ws + WS_WBS); bf16* Wba = (bf16*)(ws + WS_WBA);
    bf16* Wout = (bf16*)(ws + WS_WOUT); bf16* Wgu2 = (bf16*)(ws + WS_WGU2); bf16* Wd2 = (bf16*)(ws + WS_WD2);
    bf16* XN = (bf16*)(ws + WS_XN); bf16* ZB = (bf16*)(ws + WS_Z); bf16* XBC = (bf16*)(ws + WS_XBC); bf16* QB = (bf16*)(ws + WS_Q); bf16* KB = (bf16*)(ws + WS_K); bf16* VB = (bf16*)(ws + WS_V);
    float* DT = (float*)(ws + WS_DT); bf16* HALO = (bf16*)(ws + WS_HALO); bf16* ACT = (bf16*)(ws + WS_ACT); bf16* ST = (bf16*)(ws + WS_ST); bf16* GB = (bf16*)(ws + WS_G); bf16* MS = (bf16*)(ws + WS_MS);
    float* SS1 = (float*)(ws + WS_CTL + 262144); float* SS2 = (float*)(ws + WS_CTL + 393216);
    const int lo = args.ph_lo, hi = args.ph_hi;
#define IN(k) (lo <= (k) && (k) < hi)
#define SEAM(k) do { if (IN(k) && IN((k) + ((k) == 2 || (k) == 11 ? 2 : 1))) GRID_BAR(); } while (0)
    const int bx = (int)blockIdx.x;
#if PROBE_A
    unsigned long long* TS = (unsigned long long*)(ws + WS_CTL + 655360); int nts = 0;
#define STAMP() do { if (blockIdx.x == 0 && F.tid == 0) __hip_atomic_store(TS + nts, (unsigned long long)__builtin_amdgcn_s_memrealtime(), __ATOMIC_RELAXED, __HIP_MEMORY_SCOPE_AGENT); ++nts; } while (0)
    STAMP();
#else
#define STAMP() do {} while (0)
#endif

    for (int rep_ = 0; rep_ < 1 + DUP_P0; ++rep_)
    if (IN(0)) { P0Args a{x, args.in[1], args.in[2], args.in[3], args.in[5], args.in[13], args.in[14], args.in[15], args.in[17], args.in[18], Wgu1, Wd1, Win, Wbs, Wba, Wout, Wgu2, Wd2, XN};
        p0_prologue(F, a); }
    SEAM(0); STAMP();
#if DBG_CHK
    if (IN(1)) chk::c_norm(F, 0, x, args.in[1], XN);
    if (IN(2)) chk::c_up(F, 1, XN, args.in[2], ACT);
    if (IN(3)) chk::c_down(F, 2, x, ACT, args.in[3], out);
    if (IN(4)) chk::c_norm(F, 3, out, args.in[4], XN);
    if (IN(5)) chk::c_in1(F, 4, XN, args.in[5], ZB, XBC, QB, KB, VB, DT, args.in[8]);
    if (IN(9)) { chk::c_gate(F, 5, XN, args.in[5], GB); chk::c_wt(F, args.in[5], Win); }
    if (IN(11)) chk::c_merge(F, 6, ZB, QB, GB, args.in[13], args.in[14], XN);
    if (IN(13)) chk::c_norm(F, 7, out, args.in[16], XN);
    if (IN(14)) chk::c_up(F, 8, XN, args.in[17], ACT);
#endif
    if (IN(1)) { pg8::Gemm g{XN, Wgu1, TOK, 2 * FF, DM}; pg8::StaticOrder S; S.init(TOK, 2 * FF, F.G, bx); pg8::EpiSwiglu E{ACT, nullptr};
        pg8::gemm_phase<pg8::EpiSwiglu, pg8::StaticOrder, true, true>(F.lds + RING_OFF, g, S, E); }
    SEAM(1); STAMP();
    if (IN(2)) { pg8::Gemm g{ACT, Wd1, TOK, DM, FF}; pg8::StaticOrder S; S.init(TOK, DM, F.G, bx); pg8::EpiResidNorm E{x, out, 0.5f, XN, args.in[4], SS1};
        pg8::gemm_phase<pg8::EpiResidNorm, pg8::StaticOrder, true, true>(F.lds + RING_OFF, g, S, E); }
    SEAM(2); STAMP();
    if (IN(4)) { pg8::Gemm g{XN, Win, TOK, NIN1, DM}; pg8::StaticOrder S; S.init(TOK, NIN1, F.G, bx); pg8::EpiIn1 E{ZB, XBC, QB, KB, VB, HALO, DT, args.in[8], SS1};
        pg8::gemm_phase<pg8::EpiIn1, pg8::StaticOrder, true, true>(F.lds + RING_OFF, g, S, E); }
    SEAM(4); STAMP();
    if (IN(5)) {
#if !DBG_SSD
        conv_pass(F, XBC, HALO, args.in[6], args.in[7]);
#endif
#if DBG_ATT
        naive::attn_seq(F, QB, KB, VB, QB, args.in[12]);
#else
#if DUP_ATT
        att::attn_phase(F, QB, KB, VB, QB, args.in[12], args.pad == 777);
#endif
        att::attn_phase(F, QB, KB, VB, QB, args.in[12], true);
#endif
    }
    SEAM(5); STAMP();
#if DBG_SSD
    if (IN(6)) naive::conv_oop(F, XBC, KB, args.in[6], args.in[7]);
#else
    if (IN(6)) { for (int u = F.vcu; u < NB * NH * 4; u += F.G) ssd::s1_unit(F.lds + RING_OFF, XBC, DT, args.in[9], ST, u >> 6, (u >> 2) & 15, u & 3); }
#endif
    SEAM(6); STAMP();
#if DBG_SSD
    if (IN(7)) naive::ssd_seq(F, KB, DT, args.in[9], args.in[10], args.in[11], ZB);
#else
    if (IN(7)) {
#if DUP_S2
        for (int u = F.vcu; u < NB * 128 * NGRP; u += F.G) ssd::s2_unit(F.lds + RING_OFF, XBC, DT, args.in[9], args.in[10], args.in[11], ST, ZB, u >> 8, (u >> 1) & 127, u & 1, args.pad == 777);
#endif
        for (int u = F.vcu; u < NB * 128 * NGRP; u += F.G) ssd::s2_unit(F.lds + RING_OFF, XBC, DT, args.in[9], args.in[10], args.in[11], ST, ZB, u >> 8, (u >> 1) & 127, u & 1, true); }
#endif
    SEAM(7); STAMP();
    if (IN(8)) { pg8::Gemm g{XN, Win + (size_t)NIN1 * DM, TOK, NGATE, DM}; pg8::StaticOrder S; S.init(TOK, NGATE, F.G, bx); pg8::EpiGate E{GB, SS1};
        pg8::gemm_phase<pg8::EpiGate, pg8::StaticOrder, true, true>(F.lds + RING_OFF, g, S, E); }
    SEAM(8); STAMP();
    if (IN(9)) { pg8::Gemm g{ZB, Wbs, TOK, DM, DM}; pg8::StaticOrder S; S.init(TOK, DM, F.G, bx); pg8::EpiMerge<false> E{GB, nullptr, MS};
        pg8::gemm_phase<pg8::EpiMerge<false>, pg8::StaticOrder, true, true>(F.lds + RING_OFF, g, S, E); }
    if (IN(10)) { pg8::Gemm g{QB, Wba, TOK, DM, DM}; pg8::StaticOrder S; S.init(TOK, DM, F.G, bx); pg8::EpiMerge<true> E{GB + DM, MS, MS};
        pg8::gemm_phase<pg8::EpiMerge<true>, pg8::StaticOrder, true, true>(F.lds + RING_OFF, g, S, E); }
    SEAM(10); STAMP();
    if (IN(11)) { pg8::Gemm g{MS, Wout, TOK, DM, DM}; pg8::StaticOrder S; S.init(TOK, DM, F.G, bx); pg8::EpiResidNorm E{out, out, 1.0f, XN, args.in[16], SS2};
        pg8::gemm_phase<pg8::EpiResidNorm, pg8::StaticOrder, true, true>(F.lds + RING_OFF, g, S, E); }
    SEAM(11); STAMP();
    if (IN(13)) { pg8::Gemm g{XN, Wgu2, TOK, 2 * FF, DM}; pg8::StaticOrder S; S.init(TOK, 2 * FF, F.G, bx); pg8::EpiSwiglu E{ACT, SS2};
        pg8::gemm_phase<pg8::EpiSwiglu, pg8::StaticOrder, true, true>(F.lds + RING_OFF, g, S, E); }
    SEAM(13); STAMP();
    if (IN(14)) { pg8::Gemm g{ACT, Wd2, TOK, DM, FF}; pg8::StaticOrder S; S.init(TOK, DM, F.G, bx); pg8::EpiResid E{out, out, 0.5f};
        pg8::gemm_phase<pg8::EpiResid, pg8::StaticOrder, true, true>(F.lds + RING_OFF, g, S, E); }
    SEAM(14); STAMP();
    if (IN(15)) { const int gw = F.vcu * NWAVES + F.wave, NGW = F.G * NWAVES; for (int m = gw; m < TOK; m += NGW) rms_row_f32_inplace(F.lane, out + (size_t)m * DM, args.in[19]);
#if PROBE_A
        { const float ta = (float)(__hip_atomic_load(TS + PROBE_A, RLX_AGENT) - __hip_atomic_load(TS + PROBE_A - 1, RLX_AGENT)) * 0.01f, tr = (float)(__hip_atomic_load(TS + PROBE_R, RLX_AGENT) - __hip_atomic_load(TS + PROBE_R - 1, RLX_AGENT)) * 0.01f;
          const float sc = 1.0f + tr * 0.001f;
          for (int m = gw; m < TOK; m += NGW) { GAS f32x4* xr = (GAS f32x4*)(out + (size_t)m * DM) + F.lane; for (int j = 0; j < 4; ++j) xr[64 * j] = xr[64 * j] * sc; }
          if (gw == 0 && F.lane == 0) { asm volatile("s_waitcnt vmcnt(0)" ::: "memory"); out[0] = out[0] + ta; } }
#endif
#if DBG_CHK
        { const unsigned fl = __hip_atomic_load(F.ctl + chk::CW_FLAG, RLX_AGENT); const unsigned cnt = __hip_atomic_load(F.ctl + chk::CW_FLAG + 64, RLX_AGENT); const float sc = 1.0f + 0.5f * (float)(cnt ? 32 - __builtin_clz(cnt) : (fl ? __builtin_ctz(fl) + 1 : 0));
          for (int m = gw; m < TOK; m += NGW) { GAS f32x4* xr = (GAS f32x4*)(out + (size_t)m * DM) + F.lane; for (int j = 0; j < 4; ++j) xr[64 * j] = xr[64 * j] * sc; } }
#endif
    }
#undef IN
#undef SEAM
#undef GRID_BAR
}

extern "C" void kernel_launch(void* const* d_in, const int* in_sizes, int n_in, void* d_out, int out_size, void* d_ws, size_t ws_size, hipStream_t stream) {
    static int grid = 0;
    if (grid == 0) {
        if (n_in != 20 || in_sizes[0] != TOK * DM || out_size != TOK * DM || ws_size < WS_END) { fprintf(stderr, "kernel_launch: unexpected shapes (n_in %d, in0 %d, out %d, ws %zu)\n", n_in, n_in > 0 ? in_sizes[0] : -1, out_size, ws_size); grid = -1; return; }
        int dev = 0, cus = 0, per_cu = 0;
        if (hipGetDevice(&dev) != hipSuccess || hipDeviceGetAttribute(&cus, hipDeviceAttributeMultiprocessorCount, dev) != hipSuccess) { grid = -1; return; }
        if (hipFuncSetAttribute((const void*)fwd_kernel, hipFuncAttributeMaxDynamicSharedMemorySize, LDS_BYTES) != hipSuccess) { fprintf(stderr, "kernel_launch: hipFuncSetAttribute failed\n"); grid = -1; return; }
        if (hipOccupancyMaxActiveBlocksPerMultiprocessor(&per_cu, (const void*)fwd_kernel, NWAVES * 64, LDS_BYTES) != hipSuccess || per_cu < 1) { fprintf(stderr, "kernel_launch: occupancy query says %d\n", per_cu); per_cu = 1; }
        (void)hipGetLastError();
        grid = cus;
    }
    if (grid < 0) return;
    if (hipMemsetAsync((char*)d_ws + WS_CTL, 0, CTL_ZERO_BYTES, stream) != hipSuccess) { fprintf(stderr, "kernel_launch: memset failed\n"); return; }
    Args a{};
    for (int i = 0; i < 20; ++i) a.in[i] = (const float*)d_in[i];
    a.out = (float*)d_out; a.ws = (unsigned char*)d_ws;
    if (N_LAUNCHES == 1) {
        a.ph_lo = 0; a.ph_hi = N_PHASES; a.li = 0;
        void* kargs[] = {&a};
        hipError_t e = hipLaunchCooperativeKernel((const void*)fwd_kernel, dim3(grid), dim3(NWAVES * 64), kargs, LDS_BYTES, stream);
        if (e != hipSuccess) fprintf(stderr, "kernel_launch: cooperative launch failed: %s (grid %d)\n", hipGetErrorString(e), grid);
    } else {
        for (int li = 0; li < N_PHASES; ++li) {
            a.ph_lo = li; a.ph_hi = li + 1; a.li = li;
            hipLaunchKernelGGL(fwd_kernel, dim3(grid), dim3(NWAVES * 64), LDS_BYTES, stream, a);
        }
    }
}
```

```cpp
#include <hip/hip_runtime.h>
#include <cstdio>
#include <cstdint>
#define MK_N_LAUNCHES 1
#define DBG_ATT 0
#define DBG_SSD 0
#define DBG_CHK 0
#define PROBE_A 0
#define PROBE_R 0
#define DUP_ATT 0
#define DUP_S2 0
#define DUP_P0 0
#define DUP_CONV 0
#define S2_PROBE_MODE 0
constexpr int NB = 4, SEQ = 8192, DM = 1024, NH = 16, HD = 64, FF = 2816, NST = 128, NGRP = 2;
constexpr int TOK = NB * SEQ;
constexpr int XBCW = 1536;
constexpr int NIN1 = 5888;
constexpr int NGATE = 2048;
constexpr int NCHUNK = TOK / 64;
constexpr float RMS_EPS = 1e-6f;
constexpr float LOG2E = 1.4426950408889634f;
constexpr float QSCALE = 0.125f * LOG2E;
namespace pg8 {
#define PG8_LAS __attribute__((address_space(3)))
typedef unsigned short bf16_t;
typedef short bf16x8 __attribute__((ext_vector_type(8)));
typedef float f32x4 __attribute__((ext_vector_type(4)));
typedef unsigned u32x4 __attribute__((ext_vector_type(4)));
constexpr int BM = 256, BK = 64, HALF = 128, HTB = HALF * BK * 2  , STAGE_BYTES = 8 * HTB, NXCD = 8, WGM = 8;

__host__ __device__ __forceinline__ int lds_byte(int r, int c) { const int st = (r >> 4) * 2 + (c >> 5), rr = r & 15, cc = c & 31, ob = rr * 64 + cc * 2; return st * 1024 + (ob ^ (((ob >> 9) & 1) << 5)); }
__host__ __device__ __forceinline__ void stage_rc(int b, int& R, int& C) { const int st = b / 1024, sb = b % 1024, swz = sb ^ (((sb >> 9) & 1) << 5); R = (st >> 1) * 16 + swz / 64; C = (st & 1) * 32 + (swz % 64) / 2; }
__host__ __device__ __forceinline__ int perm32(int rho) { const int n = rho >> 4, i = rho & 15; return 8 * (i >> 2) + 4 * n + (i & 3); }

struct Unit { int pm, pn; };
struct Gemm { const bf16_t* A; const bf16_t* Bt; int M, N, K; };

struct StaticOrder {
    int nM, nN, nwg, G, c;
    __host__ __device__ void init(int M, int N, int G_, int c_) { nM = M / BM; nN = N / BM; nwg = nM * nN; G = G_; c = c_; }
    __host__ __device__ bool next(int i, Unit& u) const {
        const long L = (long)i * G + c; if (L >= nwg) return false;
        int wgid = (int)L; { const int q = nwg / NXCD, r = nwg % NXCD, xcd = wgid % NXCD, off = wgid / NXCD; wgid = (xcd < r ? xcd * (q + 1) : r * (q + 1) + (xcd - r) * q) + off; }
        const int nig = WGM * nN, gid = wgid / nig, fm = gid * WGM, gsz = (nM - fm) < WGM ? (nM - fm) : WGM;
        u.pm = fm + ((wgid % nig) % gsz); u.pn = (wgid % nig) / gsz; return true;
    }
    __device__ __forceinline__ void a_ready(const Unit&) const {}
    __device__ __forceinline__ void done(const Unit&) const {}
};
typedef float f32x2 __attribute__((ext_vector_type(2)));
typedef __bf16 bf16x2v __attribute__((ext_vector_type(2)));
__device__ __forceinline__ unsigned cvt_pk_bf16(float lo, float hi) { f32x2 v = {lo, hi}; bf16x2v b = __builtin_convertvector(v, bf16x2v); return __builtin_bit_cast(unsigned, b); }
__device__ __forceinline__ float sigm(float x) { return __builtin_amdgcn_rcpf(1.0f + __builtin_amdgcn_exp2f(-x * 1.4426950408889634f)); }
__device__ __forceinline__ float silu(float x) { return x * sigm(x); }
__device__ __forceinline__ u32x4 pack8(const f32x4 a, const f32x4 b) { u32x4 w; w.x = cvt_pk_bf16(a[0], a[1]); w.y = cvt_pk_bf16(a[2], a[3]); w.z = cvt_pk_bf16(b[0], b[1]); w.w = cvt_pk_bf16(b[2], b[3]); return w; }
__device__ __forceinline__ float bf_lo(unsigned w) { return __uint_as_float(w << 16); }
__device__ __forceinline__ float bf_hi(unsigned w) { return __uint_as_float(w & 0xffff0000u); }
__device__ __forceinline__ void unpack8(const u32x4 w, f32x4& a, f32x4& b) { a[0] = bf_lo(w.x); a[1] = bf_hi(w.x); a[2] = bf_lo(w.y); a[3] = bf_hi(w.y); b[0] = bf_lo(w.z); b[1] = bf_hi(w.z); b[2] = bf_lo(w.w); b[3] = bf_hi(w.w); }
__device__ __forceinline__ float softplus_f(float x) { return fmaxf(x, 0.f) + log1pf(__expf(-fabsf(x))); }

__device__ __forceinline__ float rs_of(float ss) { return 1.0f / sqrtf(ss * (1.f / DM) + RMS_EPS); }
__device__ __forceinline__ void load_rs(const float* ss, int row0, float (&rs)[2][4]) {
#pragma unroll
    for (int ai = 0; ai < 2; ++ai)
#pragma unroll
        for (int m = 0; m < 4; ++m) rs[ai][m] = ss ? ss[row0 + ai * HALF + m * 16] : 0.f;
#pragma unroll
    for (int ai = 0; ai < 2; ++ai)
#pragma unroll
        for (int m = 0; m < 4; ++m) rs[ai][m] = ss ? rs_of(rs[ai][m]) : 1.0f;
}
struct EpiSwiglu {
    static constexpr bool PERM = true, AFTER_DRAIN = false;
    bf16_t* O; const float* ss;
    __device__ __forceinline__ void operator()(const f32x4 (&acc)[2][2][4][2], const Unit& u, int wr, int wc, int fr, int fq) const {
        const int row0 = u.pm * BM + wr * 64 + fr, col0 = u.pn * 128 + wc * 32 + 8 * fq;
        float rs[2][4]; load_rs(ss, row0, rs);
#pragma unroll
        for (int ai = 0; ai < 2; ++ai)
#pragma unroll
            for (int m = 0; m < 4; ++m) { const int row = row0 + ai * HALF + m * 16; bf16_t* rowp = O + (size_t)row * FF + col0; const float r_ = rs[ai][m];
                f32x4 v0, v1;
#pragma unroll
                for (int j = 0; j < 4; ++j) { v0[j] = silu(acc[ai][0][m][0][j] * r_) * (acc[ai][1][m][0][j] * r_); v1[j] = silu(acc[ai][0][m][1][j] * r_) * (acc[ai][1][m][1][j] * r_); }
                *(u32x4*)rowp = pack8(v0, v1); }
    }
};
struct EpiResidNorm {
    static constexpr bool PERM = true, AFTER_DRAIN = false;
    const float* base; float* out; float scale; bf16_t* XN; const float* w; float* ss;
    __device__ __forceinline__ void operator()(const f32x4 (&acc)[2][2][4][2], const Unit& u, int wr, int wc, int fr, int fq) const {
        const int row0 = u.pm * BM + wr * 64 + fr, col0 = u.pn * BM + wc * 32 + 8 * fq;
        f32x4 wv[2][2];
#pragma unroll
        for (int bj = 0; bj < 2; ++bj)
#pragma unroll
            for (int n = 0; n < 2; ++n) wv[bj][n] = *(const f32x4*)(w + col0 + bj * HALF + 4 * n);
#pragma unroll
        for (int ai = 0; ai < 2; ++ai) {
            f32x4 bs[4][2][2];
#pragma unroll
            for (int m = 0; m < 4; ++m)
#pragma unroll
                for (int bj = 0; bj < 2; ++bj)
#pragma unroll
                    for (int n = 0; n < 2; ++n) bs[m][bj][n] = *(const f32x4*)(base + (size_t)(row0 + ai * HALF + m * 16) * DM + col0 + bj * HALF + 4 * n);
#pragma unroll
            for (int m = 0; m < 4; ++m) { const int row = row0 + ai * HALF + m * 16; const size_t off = (size_t)row * DM + col0; float s = 0.f;
#pragma unroll
                for (int bj = 0; bj < 2; ++bj) { f32x4 v[2];
#pragma unroll
                    for (int n = 0; n < 2; ++n) { v[n] = bs[m][bj][n] + acc[ai][bj][m][n] * scale; *(f32x4*)(out + off + bj * HALF + 4 * n) = v[n];
                        s += (v[n][0] * v[n][0] + v[n][1] * v[n][1]) + (v[n][2] * v[n][2] + v[n][3] * v[n][3]); }
                    *(u32x4*)(XN + off + bj * HALF) = pack8(v[0] * wv[bj][0], v[1] * wv[bj][1]); }
                s += __shfl_xor(s, 16); s += __shfl_xor(s, 32);
                if (fq == 0) atomicAdd(ss + row, s); }
            asm volatile("" ::: "memory"); }
    }
};
struct EpiResid {
    static constexpr bool PERM = true, AFTER_DRAIN = false;
    const float* base; float* out; float scale;
    __device__ __forceinline__ void operator()(const f32x4 (&acc)[2][2][4][2], const Unit& u, int wr, int wc, int fr, int fq) const {
        const int row0 = u.pm * BM + wr * 64 + fr, col0 = u.pn * BM + wc * 32 + 8 * fq;
#pragma unroll
        for (int ai = 0; ai < 2; ++ai) {
            f32x4 bs[4][2][2];
#pragma unroll
            for (int m = 0; m < 4; ++m)
#pragma unroll
                for (int bj = 0; bj < 2; ++bj)
#pragma unroll
                    for (int n = 0; n < 2; ++n) bs[m][bj][n] = *(const f32x4*)(base + (size_t)(row0 + ai * HALF + m * 16) * DM + col0 + bj * HALF + 4 * n);
#pragma unroll
            for (int m = 0; m < 4; ++m) { const size_t off = (size_t)(row0 + ai * HALF + m * 16) * DM + col0;
#pragma unroll
                for (int bj = 0; bj < 2; ++bj)
#pragma unroll
                    for (int n = 0; n < 2; ++n) *(f32x4*)(out + off + bj * HALF + 4 * n) = bs[m][bj][n] + acc[ai][bj][m][n] * scale; }
            asm volatile("" ::: "memory"); }
    }
};
struct EpiIn1 {
    static constexpr bool PERM = true, AFTER_DRAIN = false;
    bf16_t *Z, *XBC, *Q, *K, *V, *HALO; float* DT; const float* dt_bias; const float* ss;
    __device__ __forceinline__ void operator()(const f32x4 (&acc)[2][2][4][2], const Unit& u, int wr, int wc, int fr, int fq) const {
        const int row0 = u.pm * BM + wr * 64 + fr, pn = u.pn, c8 = wc * 32 + 8 * fq;
        float rs[2][4]; load_rs(ss, row0, rs);
        if (pn < 22) {
            bf16_t* base; int ld, colt; float sc = 1.f; bool halo = false;
            if (pn < 4) { base = Z; ld = DM; colt = pn * 256; }
            else if (pn < 10) { base = XBC; ld = XBCW; colt = (pn - 4) * 256; halo = true; }
            else if (pn < 14) { base = Q; ld = DM; colt = (pn - 10) * 256; sc = QSCALE; }
            else if (pn < 18) { base = K; ld = DM; colt = (pn - 14) * 256; }
            else { base = V; ld = DM; colt = (pn - 18) * 256; }
#pragma unroll
            for (int ai = 0; ai < 2; ++ai)
#pragma unroll
                for (int m = 0; m < 4; ++m) { const int row = row0 + ai * HALF + m * 16; const float rsc = rs[ai][m] * sc;
#pragma unroll
                    for (int bj = 0; bj < 2; ++bj) { const u32x4 w = pack8(acc[ai][bj][m][0] * rsc, acc[ai][bj][m][1] * rsc); const int col = colt + bj * HALF + c8;
                        *(u32x4*)(base + (size_t)row * ld + col) = w;
                        if (halo && (row & 63) >= 61) *(u32x4*)(HALO + (size_t)(((row >> 6) + 1) * 3 + ((row & 63) - 61)) * XBCW + col) = w; } }
        } else {
            if (wc == 0 && fq < 2) {
#pragma unroll
                for (int ai = 0; ai < 2; ++ai)
#pragma unroll
                    for (int m = 0; m < 4; ++m) { const int row = row0 + ai * HALF + m * 16; const float r_ = rs[ai][m];
#pragma unroll
                        for (int n = 0; n < 2; ++n) { const int i0 = 8 * fq + 4 * n; const f32x4 bv = *(const f32x4*)(dt_bias + i0); f32x4 o;
#pragma unroll
                            for (int j = 0; j < 4; ++j) o[j] = softplus_f(acc[ai][0][m][n][j] * r_ + bv[j]);
                            *(f32x4*)(DT + (size_t)row * 16 + i0) = o; } }
            }
        }
    }
};
struct EpiGate {
    static constexpr bool PERM = true, AFTER_DRAIN = false;
    bf16_t* G; const float* ss;
    __device__ __forceinline__ void operator()(const f32x4 (&acc)[2][2][4][2], const Unit& u, int wr, int wc, int fr, int fq) const {
        const int row0 = u.pm * BM + wr * 64 + fr, col0 = u.pn * BM + wc * 32 + 8 * fq;
        float rs[2][4]; load_rs(ss, row0, rs);
#pragma unroll
        for (int ai = 0; ai < 2; ++ai)
#pragma unroll
            for (int m = 0; m < 4; ++m) { const int row = row0 + ai * HALF + m * 16; bf16_t* rowp = G + (size_t)row * NGATE + col0; const float r_ = rs[ai][m];
#pragma unroll
                for (int bj = 0; bj < 2; ++bj) { f32x4 v0, v1;
#pragma unroll
                    for (int j = 0; j < 4; ++j) { v0[j] = sigm(acc[ai][bj][m][0][j] * r_); v1[j] = sigm(acc[ai][bj][m][1][j] * r_); }
                    *(u32x4*)(rowp + bj * HALF) = pack8(v0, v1); } }
    }
};
template <bool ADD> struct EpiMerge {
    static constexpr bool PERM = true, AFTER_DRAIN = false;
    const bf16_t* G; const bf16_t* MS; bf16_t* O;
    __device__ __forceinline__ void operator()(const f32x4 (&acc)[2][2][4][2], const Unit& u, int wr, int wc, int fr, int fq) const {
        const int row0 = u.pm * BM + wr * 64 + fr, col0 = u.pn * BM + wc * 32 + 8 * fq;
#pragma unroll
        for (int ai = 0; ai < 2; ++ai) {
            u32x4 gv[4][2], mv[4][2];
#pragma unroll
            for (int m = 0; m < 4; ++m)
#pragma unroll
                for (int bj = 0; bj < 2; ++bj) { const size_t row = (size_t)(row0 + ai * HALF + m * 16); const int col = col0 + bj * HALF;
                    gv[m][bj] = *(const u32x4*)(G + row * NGATE + col); if (ADD) mv[m][bj] = *(const u32x4*)(MS + row * DM + col); }
#pragma unroll
            for (int m = 0; m < 4; ++m)
#pragma unroll
                for (int bj = 0; bj < 2; ++bj) { const size_t row = (size_t)(row0 + ai * HALF + m * 16); const int col = col0 + bj * HALF;
                    f32x4 g0, g1; unpack8(gv[m][bj], g0, g1);
                    f32x4 v0 = acc[ai][bj][m][0] * g0, v1 = acc[ai][bj][m][1] * g1;
                    if (ADD) { f32x4 m0, m1; unpack8(mv[m][bj], m0, m1); v0 += m0; v1 += m1; }
                    *(u32x4*)(O + row * DM + col) = pack8(v0, v1); }
            asm volatile("" ::: "memory"); }
    }
};
struct EpiNull {
    static constexpr bool PERM = true, AFTER_DRAIN = false;
    __device__ __forceinline__ void operator()(const f32x4 (&acc)[2][2][4][2], const Unit& u, int wr, int wc, int fr, int fq) const {
#pragma unroll
        for (int ai = 0; ai < 2; ++ai)
#pragma unroll
            for (int bj = 0; bj < 2; ++bj)
#pragma unroll
                for (int m = 0; m < 4; ++m)
#pragma unroll
                    for (int n = 0; n < 2; ++n) asm volatile("" :: "v"(acc[ai][bj][m][n]));
    }
};
template <class Epi, class Sched, bool ALIGN_EPI = false, bool SP2 = false>
__device__ __forceinline__ void gemm_phase(PG8_LAS unsigned char* lds, const Gemm g, const Sched& S, const Epi& E) {
    const int tid = threadIdx.x, wid = __builtin_amdgcn_readfirstlane(tid >> 6), lane = tid & 63, wr = wid >> 2, wc = wid & 3, fr = lane & 15, fq = lane >> 4;
    const int K = g.K, nt = K / BK;
    unsigned voffA[2], voffB[2];
#pragma unroll
    for (int i = 0; i < 2; ++i) { int R, C; stage_rc(tid * 16 + i * 8192, R, C); const int Rb = Epi::PERM ? ((R & ~31) + perm32(R & 31)) : R;
        voffA[i] = (unsigned)(R * K + C) * 2u; voffB[i] = (unsigned)(Rb * K + C) * 2u; }
    const size_t kstep = (size_t)(BK * 2);
    const size_t hstep = (size_t)HALF * K * 2;
    const size_t tstep = 2 * hstep;
    const unsigned ldsw = (unsigned)wid * 1024u;
    const int aoff = lds_byte(wr * 64 + fr, fq * 8), boff = lds_byte(wc * 32 + fr, fq * 8);
#define PG8_SA(b, h) (((b) * 2 + (h)) * HTB)
#define PG8_SB(b, h) ((4 + (b) * 2 + (h)) * HTB)
#define PG8_STAGE(bufoff, gbase, voff) do { _Pragma("unroll") for (int _i = 0; _i < 2; ++_i) \
        __builtin_amdgcn_global_load_lds((const unsigned*)((const char*)(gbase) + (voff)[_i]), (PG8_LAS unsigned*)(lds + (bufoff) + ldsw + _i * 8192), 16, 0, 0); } while (0)
#define PG8_LDA(dst, b, h) do { _Pragma("unroll") for (int m = 0; m < 4; ++m) _Pragma("unroll") for (int k = 0; k < 2; ++k) dst[m][k] = *(const PG8_LAS bf16x8*)(lds + PG8_SA(b, h) + aoff + m * 2048 + k * 1024); } while (0)
#define PG8_LDB(dst, b, h) do { _Pragma("unroll") for (int n = 0; n < 2; ++n) _Pragma("unroll") for (int k = 0; k < 2; ++k) dst[n][k] = *(const PG8_LAS bf16x8*)(lds + PG8_SB(b, h) + boff + n * 2048 + k * 1024); } while (0)
#define PG8_MMA(ai, bj, At, Bt) do { __builtin_amdgcn_s_setprio(1); _Pragma("unroll") for (int m = 0; m < 4; ++m) _Pragma("unroll") for (int n = 0; n < 2; ++n) _Pragma("unroll") for (int k = 0; k < 2; ++k) \
        acc[ai][bj][m][n] = __builtin_amdgcn_mfma_f32_16x16x32_bf16(Bt[n][k], At[m][k], acc[ai][bj][m][n], 0, 0, 0); __builtin_amdgcn_s_setprio(0); } while (0)
#define PG8_WAIT_V(n) asm volatile("s_waitcnt vmcnt(" #n ")" ::: "memory")
#define PG8_WAIT_L(n) asm volatile("s_waitcnt lgkmcnt(" #n ")" ::: "memory")
#define PG8_BAR __builtin_amdgcn_s_barrier()
#define PG8_SCHED __builtin_amdgcn_sched_barrier(0)
    Unit cur, nxt; int ui = 0;
    if (!S.next(0, cur)) return;
    f32x4 acc[2][2][4][2];
#pragma unroll
    for (int a = 0; a < 2; ++a)
#pragma unroll
        for (int b = 0; b < 2; ++b)
#pragma unroll
            for (int m = 0; m < 4; ++m)
#pragma unroll
                for (int n = 0; n < 2; ++n) acc[a][b][m][n] = (f32x4){0.f, 0.f, 0.f, 0.f};
    bf16x8 At[4][2], B0[2][2], B1[2][2];
    const char* cA = (const char*)g.A + (size_t)cur.pm * tstep; const char* cB = (const char*)g.Bt + (size_t)cur.pn * tstep;
    S.a_ready(cur);
    if constexpr (SP2) {
        PG8_STAGE(PG8_SB(0, 0), cB, voffB); PG8_STAGE(PG8_SB(0, 1), cB + hstep, voffB); PG8_STAGE(PG8_SA(0, 0), cA, voffA); PG8_STAGE(PG8_SA(0, 1), cA + hstep, voffA);
        if (wr == 1) PG8_BAR;
        PG8_WAIT_V(2); PG8_BAR;
        PG8_STAGE(PG8_SB(1, 0), cB + kstep, voffB); PG8_STAGE(PG8_SA(1, 0), cA + kstep, voffA); PG8_STAGE(PG8_SB(1, 1), cB + hstep + kstep, voffB);
        PG8_WAIT_V(6); PG8_BAR;
    } else {
        PG8_STAGE(PG8_SB(0, 0), cB, voffB); PG8_STAGE(PG8_SA(0, 0), cA, voffA); PG8_STAGE(PG8_SB(0, 1), cB + hstep, voffB); PG8_STAGE(PG8_SA(0, 1), cA + hstep, voffA);
        if (wr == 1) PG8_BAR;
        PG8_WAIT_V(4); PG8_BAR;
        PG8_STAGE(PG8_SB(1, 0), cB + kstep, voffB); PG8_STAGE(PG8_SA(1, 0), cA + kstep, voffA); PG8_STAGE(PG8_SB(1, 1), cB + hstep + kstep, voffB);
        PG8_WAIT_V(6); PG8_BAR;
    }
    for (;;) {
        const bool has_next = S.next(ui + 1, nxt);
        const char* nA = has_next ? (const char*)g.A + (size_t)nxt.pm * tstep : cA; const char* nB = has_next ? (const char*)g.Bt + (size_t)nxt.pn * tstep : cB;
        for (int t = 0; t < nt; t += 2) {
            const bool last = (t == nt - 2);
            const char* a1 = cA + (size_t)(t + 1) * kstep;
            const char* a2 = last ? nA : cA + (size_t)(t + 2) * kstep; const char* b2 = last ? nB : cB + (size_t)(t + 2) * kstep;
            const char* a3 = a2 + kstep; const char* b3 = b2 + kstep;
            if (last && has_next) S.a_ready(nxt);
            if constexpr (SP2) {
            PG8_LDB(B0, 0, 0); PG8_LDB(B1, 0, 1); PG8_SCHED; PG8_LDA(At, 0, 0); PG8_STAGE(PG8_SA(1, 1), a1 + hstep, voffA);
            PG8_WAIT_V(8); PG8_WAIT_L(0); PG8_BAR; PG8_MMA(0, 0, At, B0); PG8_MMA(0, 1, At, B1); PG8_BAR; PG8_SCHED;
            PG8_LDA(At, 0, 1); PG8_STAGE(PG8_SB(0, 0), b2, voffB); PG8_STAGE(PG8_SB(0, 1), b2 + hstep, voffB); PG8_STAGE(PG8_SA(0, 0), a2, voffA);
            PG8_WAIT_V(8); PG8_WAIT_L(0); PG8_BAR; PG8_MMA(1, 0, At, B0); PG8_MMA(1, 1, At, B1); PG8_BAR; PG8_SCHED;
            PG8_LDB(B0, 1, 0); PG8_LDB(B1, 1, 1); PG8_SCHED; PG8_LDA(At, 1, 0); PG8_STAGE(PG8_SA(0, 1), a2 + hstep, voffA);
            PG8_WAIT_V(8); PG8_WAIT_L(0); PG8_BAR; PG8_MMA(0, 0, At, B0); PG8_MMA(0, 1, At, B1); PG8_BAR; PG8_SCHED;
            PG8_LDA(At, 1, 1); PG8_STAGE(PG8_SB(1, 0), b3, voffB); PG8_STAGE(PG8_SB(1, 1), b3 + hstep, voffB); PG8_STAGE(PG8_SA(1, 0), a3, voffA);
            PG8_WAIT_V(8); PG8_WAIT_L(0); PG8_BAR; PG8_MMA(1, 0, At, B0); PG8_MMA(1, 1, At, B1); PG8_BAR; PG8_SCHED;
            } else {
            PG8_LDB(B0, 0, 0); PG8_SCHED; PG8_LDA(At, 0, 0); PG8_STAGE(PG8_SA(1, 1), a1 + hstep, voffA);
            PG8_WAIT_L(8); PG8_BAR; PG8_WAIT_L(0); PG8_MMA(0, 0, At, B0); PG8_BAR; PG8_SCHED;
            PG8_LDB(B1, 0, 1); PG8_STAGE(PG8_SB(0, 0), b2, voffB);
            PG8_BAR; PG8_WAIT_L(0); PG8_MMA(0, 1, At, B1); PG8_BAR;
            PG8_LDA(At, 0, 1); PG8_STAGE(PG8_SA(0, 0), a2, voffA);
            PG8_BAR; PG8_WAIT_L(0); PG8_MMA(1, 0, At, B0); PG8_BAR; PG8_SCHED;
            PG8_STAGE(PG8_SB(0, 1), b2 + hstep, voffB);
            PG8_WAIT_V(6); PG8_BAR; PG8_MMA(1, 1, At, B1); PG8_BAR;
            PG8_LDB(B0, 1, 0); PG8_SCHED; PG8_LDA(At, 1, 0); PG8_STAGE(PG8_SA(0, 1), a2 + hstep, voffA);
            PG8_WAIT_L(8); PG8_BAR; PG8_WAIT_L(0); PG8_MMA(0, 0, At, B0); PG8_BAR; PG8_SCHED;
            PG8_LDB(B1, 1, 1); PG8_STAGE(PG8_SB(1, 0), b3, voffB);
            PG8_BAR; PG8_WAIT_L(0); PG8_MMA(0, 1, At, B1); PG8_BAR;
            PG8_LDA(At, 1, 1); PG8_STAGE(PG8_SA(1, 0), a3, voffA);
            PG8_BAR; PG8_WAIT_L(0); PG8_MMA(1, 0, At, B0); PG8_BAR; PG8_SCHED;
            PG8_STAGE(PG8_SB(1, 1), b3 + hstep, voffB);
            PG8_WAIT_V(6); PG8_BAR; PG8_MMA(1, 1, At, B1); PG8_BAR;
            }
        }
        if constexpr (ALIGN_EPI) { if (wr == 0) PG8_BAR; }
        if constexpr (!Epi::AFTER_DRAIN) { E(acc, cur, wr, wc, fr, fq); S.done(cur); }
        if (!has_next) break;
#pragma unroll
        for (int a = 0; a < 2; ++a)
#pragma unroll
            for (int b = 0; b < 2; ++b)
#pragma unroll
                for (int m = 0; m < 4; ++m)
#pragma unroll
                    for (int n = 0; n < 2; ++n) acc[a][b][m][n] = (f32x4){0.f, 0.f, 0.f, 0.f};
        cur = nxt; cA = nA; cB = nB; ++ui;
        if constexpr (ALIGN_EPI) { if (wr == 1) PG8_BAR; }
    }
    PG8_WAIT_V(0);
    if constexpr (!ALIGN_EPI) { if (wr == 0) PG8_BAR; }
    PG8_BAR;
    if constexpr (Epi::AFTER_DRAIN) { E.fused(acc, cur, wr, wc, fr, fq, lds, wid, lane); S.done(cur); }
#undef PG8_SA
#undef PG8_SB
#undef PG8_STAGE
#undef PG8_LDA
#undef PG8_LDB
#undef PG8_MMA
#undef PG8_WAIT_V
#undef PG8_WAIT_L
#undef PG8_BAR
#undef PG8_SCHED
}
}
constexpr int NWAVES = 8;
#ifndef MK_N_LAUNCHES
#define MK_N_LAUNCHES 1
#endif
constexpr int N_PHASES = 16;
constexpr int N_LAUNCHES = MK_N_LAUNCHES;

constexpr size_t MiB = 1u << 20;
constexpr size_t WS_CTL = 0, CTL_ZERO_BYTES = 1 * MiB;
constexpr size_t WS_WGU1 = 1 * MiB;
constexpr size_t WS_WD1  = 12 * MiB;
constexpr size_t WS_WIN  = 18 * MiB;
constexpr size_t WS_WBS  = 34 * MiB, WS_WBA = 36 * MiB, WS_WOUT = 38 * MiB;
constexpr size_t WS_WGU2 = 40 * MiB, WS_WD2 = 51 * MiB;
constexpr size_t WS_XN   = 57 * MiB;
constexpr size_t WS_Z    = 121 * MiB;
constexpr size_t WS_XBC  = 185 * MiB;
constexpr size_t WS_Q    = 281 * MiB;
constexpr size_t WS_K    = 345 * MiB, WS_V = 409 * MiB;
constexpr size_t WS_DT   = 473 * MiB;
constexpr size_t WS_HALO = 475 * MiB;
constexpr size_t WS_ACT  = 121 * MiB;
constexpr size_t WS_ST   = 345 * MiB;
constexpr size_t WS_G    = 345 * MiB;
constexpr size_t WS_MS   = 185 * MiB;
constexpr size_t WS_END  = 480 * MiB;
constexpr int CW_BAR = 4096;

constexpr int RING_OFF = 0, RING_BYTES = 151552;
constexpr int LDSCTL_OFF = RING_BYTES, MISC_OFF = LDSCTL_OFF + 320;
constexpr int LDS_BYTES = 155648;

#define GAS __attribute__((address_space(1)))
#define LAS __attribute__((address_space(3)))
typedef unsigned short bf16;
typedef unsigned v4u __attribute__((ext_vector_type(4)));
typedef float f32x4 __attribute__((ext_vector_type(4)));
typedef short bf16x8 __attribute__((ext_vector_type(8)));
typedef GAS unsigned gu32;
typedef GAS unsigned long long gu64;
#define RLX_AGENT __ATOMIC_RELAXED, __HIP_MEMORY_SCOPE_AGENT
#define LDS_WAIT() asm volatile("s_waitcnt lgkmcnt(0)" ::: "memory")
#define VM_WAIT() asm volatile("s_waitcnt vmcnt(0)" ::: "memory")
__device__ __forceinline__ unsigned long long rt() { return __builtin_amdgcn_s_memrealtime(); }
__device__ __forceinline__ unsigned f2bf(float f) { unsigned u = __builtin_bit_cast(unsigned, f); return (u + 0x7fffu + ((u >> 16) & 1u)) >> 16; }
__device__ __forceinline__ unsigned pk2(float lo, float hi) { return f2bf(lo) | (f2bf(hi) << 16); }
#define XB_TMO      128
#define XB_XCNT(j)  (256  + 64 * (j))
#define XB_XSUB(j)  (1280 + 64 * (j))
#define XB_XGEN(j)  (2304 + 64 * (j))
#define XB_TOP      3328
#define XB_TOPGEN   3392
#define XCD_BAR_WORDS 3456
#define XB_SPIN_CAP (1u << 22)

__device__ __forceinline__ unsigned xb_ld(unsigned* p)              { return __hip_atomic_load(p, __ATOMIC_RELAXED, __HIP_MEMORY_SCOPE_AGENT); }
__device__ __forceinline__ unsigned xb_add(unsigned* p, unsigned v) { return __hip_atomic_fetch_add(p, v, __ATOMIC_RELAXED, __HIP_MEMORY_SCOPE_AGENT); }
__device__ __forceinline__ unsigned xb_xcc_id() { return (unsigned)__builtin_amdgcn_s_getreg((3 << 11) | 20) & 0xFu; }
#define XB_SPIN(cond, bar) do { unsigned _sp = 0; while (cond) { __builtin_amdgcn_s_sleep(1); \
    if ((++_sp & 255u) == 0u) { if (xb_ld(&(bar)[XB_TMO])) break; if (_sp > XB_SPIN_CAP) { atomicAdd(&(bar)[XB_TMO], 1u); break; } } } } while (0)

struct XcdBarrier {
    unsigned* bar; unsigned x;
    volatile LAS unsigned* st;
};

__device__ __forceinline__ XcdBarrier xcd_barrier_post(unsigned* bar, volatile LAS unsigned* st) {
    XcdBarrier b; b.bar = bar; b.x = xb_xcc_id(); b.st = st;
    if (threadIdx.x == 0) (void)xb_add(&bar[XB_XCNT(b.x)], 1u);
    return b;
}
__device__ __forceinline__ void xcd_barrier_complete(unsigned* bar, unsigned x, unsigned& nloc, unsigned& nx) {
    const unsigned G = gridDim.x * gridDim.y * gridDim.z;
    unsigned sum, cnt, mine, sp = 0u;
    for (;;) {
        sum = 0u; cnt = 0u; mine = 0u;
#pragma unroll
        for (unsigned j = 0; j < 16; ++j) { const unsigned c = xb_ld(&bar[XB_XCNT(j)]); sum += c; cnt += (c > 0u) ? 1u : 0u; mine = (j == x) ? c : mine; }
        if (sum == G) break;
        __builtin_amdgcn_s_sleep(1);
        if ((++sp & 255u) == 0u) { if (xb_ld(&bar[XB_TMO])) break; if (sp > XB_SPIN_CAP) { atomicAdd(&bar[XB_TMO], 1u); break; } }
    }
    nloc = mine > 0u ? mine : 1u; nx = cnt > 0u ? cnt : 1u;
}

__device__ __forceinline__ void xcd_barrier(const XcdBarrier& b) {
    asm volatile("s_waitcnt vmcnt(0)" ::: "memory");
    __syncthreads();
    if (threadIdx.x == 0) {
        unsigned* bar = b.bar;
        __builtin_amdgcn_s_waitcnt(0);
        unsigned nloc = b.st[0], nx = b.st[1];
        if (nloc == 0u) { xcd_barrier_complete(bar, b.x, nloc, nx); b.st[0] = nloc; b.st[1] = nx; }
        const unsigned old = xb_add(&bar[XB_XSUB(b.x)], 1u);
        const unsigned gen = old / nloc;
        if (old + 1u == (gen + 1u) * nloc) {
            __builtin_amdgcn_fence(__ATOMIC_RELEASE, "agent");
            asm volatile("s_waitcnt vmcnt(0)" ::: "memory");
            const unsigned og = xb_add(&bar[XB_TOP], 1u);
            const unsigned tg = og / nx;
            if (og + 1u == (tg + 1u) * nx) xb_add(&bar[XB_TOPGEN], 1u);
            else XB_SPIN(xb_ld(&bar[XB_TOPGEN]) == tg, bar);
            __builtin_amdgcn_fence(__ATOMIC_ACQUIRE, "agent");
            xb_add(&bar[XB_XGEN(b.x)], 1u);
            asm volatile("s_waitcnt vmcnt(0)" ::: "memory");
        } else {
            XB_SPIN(xb_ld(&bar[XB_XGEN(b.x)]) == gen, bar);
            __builtin_amdgcn_fence(__ATOMIC_ACQUIRE, "agent");
            asm volatile("s_waitcnt vmcnt(0)" ::: "memory");
        }
    }
    __syncthreads();
}

struct Frame {
    LAS unsigned char* lds;
    volatile LAS unsigned* MISC;
    gu32* ctl;
    int tid, lane, wave;
    int vcu, G;
};
typedef unsigned u32x2v __attribute__((ext_vector_type(2)));
typedef short s16x4 __attribute__((ext_vector_type(4)));
typedef float f32x16 __attribute__((ext_vector_type(16)));
typedef float f32x2_t __attribute__((ext_vector_type(2)));
typedef __bf16 bf16x2_t __attribute__((ext_vector_type(2)));
__device__ __forceinline__ unsigned cvtpk_s(float lo, float hi) { f32x2_t v = {lo, hi}; bf16x2_t b = __builtin_convertvector(v, bf16x2_t); return __builtin_bit_cast(unsigned, b); }
__device__ __forceinline__ float bflo(unsigned w) { return __uint_as_float(w << 16); }
__device__ __forceinline__ float bfhi(unsigned w) { return __uint_as_float(w & 0xffff0000u); }
__device__ __forceinline__ float sigm_f(float x) { return __builtin_amdgcn_rcpf(1.0f + __builtin_amdgcn_exp2f(-x * LOG2E)); }
__device__ __forceinline__ float silu_f(float x) { return x * sigm_f(x); }
#define MFMA16(a, b, c) __builtin_amdgcn_mfma_f32_16x16x32_bf16((a), (b), (c), 0, 0, 0)
#define MFMA32(a, b, c) __builtin_amdgcn_mfma_f32_32x32x16_bf16((a), (b), (c), 0, 0, 0)

__device__ __forceinline__ float wave_sum(float v) {
#pragma unroll
    for (int o = 1; o < 64; o <<= 1) v += __shfl_xor(v, o);
    return v;
}
template <int MODE> __device__ __forceinline__ int src_col(int R) {
    if (MODE == 0) return R;
    if (MODE == 1) { const int pn = R >> 8, w = R & 255; return (w >> 7) * FF + 128 * pn + (w & 127); }
    if (R < 2560) return R;
    if (R < 5632) return R + 16;
    if (R < 5648) return 2560 + (R - 5632);
    if (R < 5888) return -1;
    return 5648 + (R - 5888);
}
template <int MODE> __device__ __forceinline__ void p0_item(const float* W, int K, int Nsrc, bf16* WT, int nblk, LAS float* scr, int item, int lane) {
    const int kb = item / nblk, nb = item - kb * nblk, k0 = 64 * kb, n0 = 32 * nb;
    const int sc = src_col<MODE>(n0 + (lane & 31));
#pragma unroll 8
    for (int i = 0; i < 32; ++i) { const int kk = 2 * i + (lane >> 5); scr[kk * 33 + (lane & 31)] = (sc >= 0) ? W[(size_t)(k0 + kk) * Nsrc + sc] : 0.f; }
    LDS_WAIT(); asm volatile("" ::: "memory");
    const int c = lane & 7;
#pragma unroll
    for (int j = 0; j < 4; ++j) { const int n = (lane >> 3) + 8 * j; const LAS float* s = scr + (8 * c) * 33 + n;
        v4u o; o.x = pk2(s[0 * 33], s[1 * 33]); o.y = pk2(s[2 * 33], s[3 * 33]); o.z = pk2(s[4 * 33], s[5 * 33]); o.w = pk2(s[6 * 33], s[7 * 33]);
        *(GAS v4u*)(WT + (size_t)(n0 + n) * K + k0 + 8 * c) = o; }
    LDS_WAIT(); asm volatile("" ::: "memory");
}
__device__ __forceinline__ void rms_row_to_bf16(int lane, const float* xrow, const float* w, bf16* orow) {
    const GAS f32x4* xr = (const GAS f32x4*)xrow + lane; const GAS f32x4* wr = (const GAS f32x4*)w + lane;
    f32x4 v[4]; float s = 0.f;
#pragma unroll
    for (int j = 0; j < 4; ++j) { v[j] = xr[64 * j]; s += (v[j].x * v[j].x + v[j].y * v[j].y) + (v[j].z * v[j].z + v[j].w * v[j].w); }
    const float rs = 1.0f / sqrtf(wave_sum(s) * (1.f / DM) + RMS_EPS);
    GAS unsigned long long* o8 = (GAS unsigned long long*)orow + lane;
#pragma unroll
    for (int j = 0; j < 4; ++j) { const f32x4 wv = wr[64 * j];
        o8[64 * j] = (unsigned long long)pk2(v[j].x * rs * wv.x, v[j].y * rs * wv.y) | ((unsigned long long)pk2(v[j].z * rs * wv.z, v[j].w * rs * wv.w) << 32); }
}
__device__ __forceinline__ void rms_row_f32_inplace(int lane, float* xrow, const float* w) {
    GAS f32x4* xr = (GAS f32x4*)xrow + lane; const GAS f32x4* wr = (const GAS f32x4*)w + lane;
    f32x4 v[4]; float s = 0.f;
#pragma unroll
    for (int j = 0; j < 4; ++j) { v[j] = xr[64 * j]; s += (v[j].x * v[j].x + v[j].y * v[j].y) + (v[j].z * v[j].z + v[j].w * v[j].w); }
    const float rs = 1.0f / sqrtf(wave_sum(s) * (1.f / DM) + RMS_EPS);
#pragma unroll
    for (int j = 0; j < 4; ++j) { const f32x4 wv = wr[64 * j]; xr[64 * j] = (v[j] * rs) * wv; }
}
__device__ __forceinline__ void norm_pass(Frame& F, const float* src, const float* w, bf16* dst) {
    const int gw = F.vcu * NWAVES + F.wave, NGW = F.G * NWAVES;
    for (int m = gw; m < TOK; m += NGW) rms_row_to_bf16(F.lane, src + (size_t)m * DM, w, dst + (size_t)m * DM);
}
struct P0Args { const float *x, *nw, *wgu1, *wd1, *win, *wbs, *wba, *wout, *wgu2, *wd2; bf16 *Wgu1, *Wd1, *Win, *Wbs, *Wba, *Wout, *Wgu2, *Wd2, *XN; };
__device__ __forceinline__ void p0_prologue(Frame& F, const P0Args& a, int parts = 3) {
    LAS float* scr = (LAS float*)(F.lds + RING_OFF + F.wave * 16384);
    const int gw = F.vcu * NWAVES + F.wave, NGW = F.G * NWAVES;
    constexpr int I_GU = (DM / 64) * (2 * FF / 32), I_D = (FF / 64) * (DM / 32), I_IN = (DM / 64) * (7936 / 32), I_SQ = (DM / 64) * (DM / 32);
    constexpr int NITEMS = 2 * I_GU + 2 * I_D + I_IN + 3 * I_SQ;
    if (parts & 1)
    for (int it = gw; it < NITEMS; it += NGW) {
        int r = it;
        if (r < I_GU) { p0_item<1>(a.wgu1, DM, 2 * FF, a.Wgu1, 2 * FF / 32, scr, r, F.lane); continue; } r -= I_GU;
        if (r < I_GU) { p0_item<1>(a.wgu2, DM, 2 * FF, a.Wgu2, 2 * FF / 32, scr, r, F.lane); continue; } r -= I_GU;
        if (r < I_D) { p0_item<0>(a.wd1, FF, DM, a.Wd1, DM / 32, scr, r, F.lane); continue; } r -= I_D;
        if (r < I_D) { p0_item<0>(a.wd2, FF, DM, a.Wd2, DM / 32, scr, r, F.lane); continue; } r -= I_D;
        if (r < I_IN) { p0_item<2>(a.win, DM, 7696, a.Win, 7936 / 32, scr, r, F.lane); continue; } r -= I_IN;
        if (r < I_SQ) { p0_item<0>(a.wbs, DM, DM, a.Wbs, DM / 32, scr, r, F.lane); continue; } r -= I_SQ;
        if (r < I_SQ) { p0_item<0>(a.wba, DM, DM, a.Wba, DM / 32, scr, r, F.lane); continue; } r -= I_SQ;
        p0_item<0>(a.wout, DM, DM, a.Wout, DM / 32, scr, r, F.lane);
    }
    if (parts & 2) norm_pass(F, a.x, a.nw, a.XN);
}
__device__ __forceinline__ void conv_pass(Frame& F, bf16* XBC, const bf16* HALO, const float* conv_w, const float* conv_b, bool do_store) {
    constexpr int NIT = NCHUNK * 192;
    for (int item = F.vcu * 512 + F.tid; item < NIT; item += F.G * 512) {
        const int chunk = item / 192, ch0 = (item - chunk * 192) * 8;
        float w0[8], w1[8], w2[8], w3[8], bb[8], r0[8], r1[8], r2[8];
#pragma unroll
        for (int e = 0; e < 8; ++e) { w0[e] = conv_w[0 * XBCW + ch0 + e]; w1[e] = conv_w[1 * XBCW + ch0 + e]; w2[e] = conv_w[2 * XBCW + ch0 + e]; w3[e] = conv_w[3 * XBCW + ch0 + e]; bb[e] = conv_b[ch0 + e]; }
        if ((chunk & 127) == 0) {
#pragma unroll
            for (int e = 0; e < 8; ++e) { r0[e] = 0.f; r1[e] = 0.f; r2[e] = 0.f; }
        } else {
            const v4u h0 = *(const GAS v4u*)(HALO + (size_t)(chunk * 3 + 0) * XBCW + ch0), h1 = *(const GAS v4u*)(HALO + (size_t)(chunk * 3 + 1) * XBCW + ch0), h2 = *(const GAS v4u*)(HALO + (size_t)(chunk * 3 + 2) * XBCW + ch0);
            r0[0] = bflo(h0.x); r0[1] = bfhi(h0.x); r0[2] = bflo(h0.y); r0[3] = bfhi(h0.y); r0[4] = bflo(h0.z); r0[5] = bfhi(h0.z); r0[6] = bflo(h0.w); r0[7] = bfhi(h0.w);
            r1[0] = bflo(h1.x); r1[1] = bfhi(h1.x); r1[2] = bflo(h1.y); r1[3] = bfhi(h1.y); r1[4] = bflo(h1.z); r1[5] = bfhi(h1.z); r1[6] = bflo(h1.w); r1[7] = bfhi(h1.w);
            r2[0] = bflo(h2.x); r2[1] = bfhi(h2.x); r2[2] = bflo(h2.y); r2[3] = bfhi(h2.y); r2[4] = bflo(h2.z); r2[5] = bfhi(h2.z); r2[6] = bflo(h2.w); r2[7] = bfhi(h2.w);
        }
        bf16* p = XBC + (size_t)chunk * 64 * XBCW + ch0;
#pragma unroll 4
        for (int t = 0; t < 64; ++t) {
            const v4u raw = *(const GAS v4u*)(p + (size_t)t * XBCW);
            float cur[8]; cur[0] = bflo(raw.x); cur[1] = bfhi(raw.x); cur[2] = bflo(raw.y); cur[3] = bfhi(raw.y); cur[4] = bflo(raw.z); cur[5] = bfhi(raw.z); cur[6] = bflo(raw.w); cur[7] = bfhi(raw.w);
            float y[8];
#pragma unroll
            for (int e = 0; e < 8; ++e) { y[e] = silu_f(bb[e] + w0[e] * r0[e] + w1[e] * r1[e] + w2[e] * r2[e] + w3[e] * cur[e]); r0[e] = r1[e]; r1[e] = r2[e]; r2[e] = cur[e]; }
            v4u o; o.x = cvtpk_s(y[0], y[1]); o.y = cvtpk_s(y[2], y[3]); o.z = cvtpk_s(y[4], y[5]); o.w = cvtpk_s(y[6], y[7]);
            if (do_store) *(GAS v4u*)(p + (size_t)t * XBCW) = o; else asm volatile("" :: "v"(o));
        }
    }
}
namespace att {
constexpr int K_OFF = 0, V_OFF = 16384, TBL_OFF = 32768, WSF_OFF = 32768 + 2048;
constexpr float ATT_THR = 8.0f;
__device__ __forceinline__ int crow(int r, int hi) { return (r & 3) + 8 * (r >> 2) + 4 * hi; }
typedef short v4i16_t __attribute__((ext_vector_type(4)));
__device__ __forceinline__ s16x4 vtr(const LAS unsigned char* p) { return __builtin_bit_cast(s16x4, __builtin_amdgcn_ds_read_tr16_b64_v4i16((LAS v4i16_t*)p)); }
__device__ __forceinline__ void attn_unit(LAS unsigned char* lds, const bf16* Q, const bf16* K, const bf16* V, bf16* O, const float* rel_bias, int b, int h, int qblk, bool do_store) {
    const int tid = threadIdx.x, lane = tid & 63, r32 = lane & 31, hi = lane >> 5; const int wid = __builtin_amdgcn_readfirstlane(tid >> 6);
    const int wq = wid >> 1, c0 = qblk * 4, cq = c0 + wq;
    const int qo = 32 * (wid & 1) + r32;
    const size_t rowq = (size_t)b * SEQ + (size_t)64 * cq + 32 * (wid & 1);
    LAS float* tbl = (LAS float*)(lds + TBL_OFF);
    LAS float* wsf = (LAS float*)(lds + WSF_OFF) + wid * 64;
    for (int i = tid; i < 257; i += 512) tbl[i] = rel_bias[h * 257 + i] * LOG2E;
    bf16x8 qr[4];
    { const bf16* Qw = Q + (rowq + r32) * DM + h * HD;
#pragma unroll
      for (int d0 = 0; d0 < 4; ++d0) qr[d0] = *(const GAS bf16x8*)(Qw + d0 * 16 + hi * 8); }
    float mref = 0.f, lrun = 0.f; bool started = false; f32x16 o0, o1;
#pragma unroll
    for (int r = 0; r < 16; ++r) { o0[r] = 0.f; o1[r] = 0.f; }
    const int t0 = (c0 >= 8) ? 0 : 8 - c0;
    const bf16* kp = K + ((size_t)b * SEQ + lane) * DM + h * HD + wid * 8;
    const bf16* vp_g = V + ((size_t)b * SEQ + 16 * (wid & 3) + (lane >> 2)) * DM + h * HD + (wid >> 2) * 32 + (lane & 3) * 8;
    v4u kv = *(const GAS v4u*)(kp + (size_t)(c0 - 8 + t0) * 64 * DM), vv = *(const GAS v4u*)(vp_g + (size_t)(c0 - 8 + t0) * 64 * DM);
    __syncthreads();
    const float cbias = tbl[256];
    for (int t = t0; t < 12; ++t) {
        const int buf = (t & 1) * 8192;
        *(LAS v4u*)(lds + K_OFF + buf + wid * 1024 + lane * 16) = kv;
        *(LAS v4u*)(lds + V_OFF + buf + wid * 1024 + lane * 16) = vv;
        if (t + 1 < 12) { kv = *(const GAS v4u*)(kp + (size_t)(c0 - 7 + t) * 64 * DM); vv = *(const GAS v4u*)(vp_g + (size_t)(c0 - 7 + t) * 64 * DM); }
        asm volatile("s_waitcnt lgkmcnt(0)\n\ts_barrier" ::: "memory");
        const int jd = wq + 8 - t;
        if (jd >= 0 && jd <= 8) {
            const LAS unsigned char* kb = lds + K_OFF + buf + hi * 1024 + r32 * 16;
            const float cinit = ((jd >= 3) ? cbias : 0.f) - mref;
            f32x16 p0, p1;
#pragma unroll
            for (int r = 0; r < 16; ++r) { p0[r] = cinit; p1[r] = cinit; }
#pragma unroll
            for (int d0 = 0; d0 < 4; ++d0) {
                const bf16x8 b0 = *(const LAS bf16x8*)(kb + d0 * 2048), b1 = *(const LAS bf16x8*)(kb + d0 * 2048 + 512);
                p0 = MFMA32(b0, qr[d0], p0); p1 = MFMA32(b1, qr[d0], p1); }
            if (jd < 3) { const int base = 64 * jd + qo + 128;
#pragma unroll
                for (int r = 0; r < 16; ++r) { const int i0 = base - crow(r, hi), i1 = i0 - 32; p0[r] += tbl[i0 < 256 ? i0 : 256]; p1[r] += tbl[i1 < 256 ? i1 : 256]; }
            }
            float ma = fmaxf(fmaxf(p0[0], p0[1]), p1[0]), mb = fmaxf(fmaxf(p0[2], p0[3]), p1[1]); ma = fmaxf(fmaxf(ma, p1[2]), p1[3]);
#pragma unroll
            for (int r = 4; r < 16; r += 4) { ma = fmaxf(fmaxf(ma, p0[r]), p0[r + 1]); mb = fmaxf(fmaxf(mb, p0[r + 2]), p0[r + 3]); ma = fmaxf(fmaxf(ma, p1[r]), p1[r + 1]); mb = fmaxf(fmaxf(mb, p1[r + 2]), p1[r + 3]); }
            float mx = fmaxf(ma, mb); mx = fmaxf(mx, __shfl_xor(mx, 32));
            if (!started || __any(mx > ATT_THR)) {
                const float dl = started ? fmaxf(mx, 0.f) : mx;
                mref += dl;
#pragma unroll
                for (int r = 0; r < 16; ++r) { p0[r] -= dl; p1[r] -= dl; }
                if (started) { const float alpha = __builtin_amdgcn_exp2f(-dl); lrun *= alpha;
                    if (hi == 0) wsf[r32] = alpha;
                    asm volatile("s_waitcnt lgkmcnt(0)" ::: "memory");
#pragma unroll
                    for (int r = 0; r < 16; ++r) { const float f = wsf[crow(r, hi)]; o0[r] *= f; o1[r] *= f; } }
                started = true;
            }
            float ls = 0.f;
#pragma unroll
            for (int r = 0; r < 16; ++r) { p0[r] = __builtin_amdgcn_exp2f(p0[r]); p1[r] = __builtin_amdgcn_exp2f(p1[r]); ls += p0[r] + p1[r]; }
            lrun += ls;
            v4u w0, w1, w2, w3;
            w0.x = cvtpk_s(p0[0], p0[1]); w0.y = cvtpk_s(p0[2], p0[3]); w0.z = cvtpk_s(p0[4], p0[5]); w0.w = cvtpk_s(p0[6], p0[7]);
            w1.x = cvtpk_s(p0[8], p0[9]); w1.y = cvtpk_s(p0[10], p0[11]); w1.z = cvtpk_s(p0[12], p0[13]); w1.w = cvtpk_s(p0[14], p0[15]);
            w2.x = cvtpk_s(p1[0], p1[1]); w2.y = cvtpk_s(p1[2], p1[3]); w2.z = cvtpk_s(p1[4], p1[5]); w2.w = cvtpk_s(p1[6], p1[7]);
            w3.x = cvtpk_s(p1[8], p1[9]); w3.y = cvtpk_s(p1[10], p1[11]); w3.z = cvtpk_s(p1[12], p1[13]); w3.w = cvtpk_s(p1[14], p1[15]);
            bf16x8 pa[4]; pa[0] = __builtin_bit_cast(bf16x8, w0); pa[1] = __builtin_bit_cast(bf16x8, w1); pa[2] = __builtin_bit_cast(bf16x8, w2); pa[3] = __builtin_bit_cast(bf16x8, w3);
            const LAS unsigned char* vp = lds + V_OFF + buf + ((lane >> 4) & 1) * 32 + (lane & 3) * 8 + (4 * hi + ((lane & 15) >> 2)) * 64;
#pragma unroll
            for (int ks = 0; ks < 4; ++ks) {
                const s16x4 l0 = vtr(vp + ks * 1024), h0 = vtr(vp + ks * 1024 + 512), l1 = vtr(vp + 4096 + ks * 1024), h1 = vtr(vp + 4096 + ks * 1024 + 512);
                const bf16x8 f0 = __builtin_shufflevector(l0, h0, 0, 1, 2, 3, 4, 5, 6, 7), f1 = __builtin_shufflevector(l1, h1, 0, 1, 2, 3, 4, 5, 6, 7);
                o0 = MFMA32(pa[ks], f0, o0); o1 = MFMA32(pa[ks], f1, o1); }
        }
    }
    { const float lt = lrun + __shfl_xor(lrun, 32);
      if (hi == 0) wsf[32 + r32] = 1.0f / lt;
      asm volatile("s_waitcnt lgkmcnt(0)" ::: "memory");
      bf16* Ow = O + rowq * DM + h * HD;
      if (do_store) {
#pragma unroll
      for (int r = 0; r < 16; ++r) { const int q = crow(r, hi); const float f = wsf[32 + q];
          Ow[(size_t)q * DM + r32] = (bf16)f2bf(o0[r] * f); Ow[(size_t)q * DM + 32 + r32] = (bf16)f2bf(o1[r] * f); } } else { asm volatile("" :: "v"(o0), "v"(o1)); } }
    __syncthreads();
}
__device__ __forceinline__ void attn_phase(Frame& F, const bf16* Q, const bf16* K, const bf16* V, bf16* O, const float* rel_bias, bool do_store) {
    for (int u = F.vcu; u < NB * NH * (SEQ / 256); u += F.G) {
        const int bh = (u & 255) >> 2, qblk = ((u & 3) << 3) + (u >> 8);
        attn_unit(F.lds + RING_OFF, Q, K, V, O, rel_bias, bh >> 4, bh & 15, qblk, do_store);
    }
}
}
namespace ssd {
constexpr int LDT = 72;
constexpr int LDC = 136;
typedef short v4i16_t __attribute__((ext_vector_type(4)));
__device__ __forceinline__ s16x4 vtr(const LAS unsigned char* p) { return __builtin_bit_cast(s16x4, __builtin_amdgcn_ds_read_tr16_b64_v4i16((LAS v4i16_t*)p)); }
__device__ __forceinline__ v4u scale8(const v4u x, float sc) { v4u o; o.x = cvtpk_s(bflo(x.x) * sc, bfhi(x.x) * sc); o.y = cvtpk_s(bflo(x.y) * sc, bfhi(x.y) * sc); o.z = cvtpk_s(bflo(x.z) * sc, bfhi(x.z) * sc); o.w = cvtpk_s(bflo(x.w) * sc, bfhi(x.w) * sc); return o; }
constexpr int S1_XROW = 144, S1_BROW = 80, S1_BUF = 64 * S1_XROW + 64 * S1_BROW;
__device__ __forceinline__ void s1_unit(LAS unsigned char* lds, const bf16* XBC, const float* DT, const float* A_log, bf16* ST, int b, int h, int nq) {
    const int tid = threadIdx.x, lane = tid & 63, fr = lane & 15, fq = lane >> 4; const int wid = __builtin_amdgcn_readfirstlane(tid >> 6);
    const int g = h >> 3, nt = wid & 1, pt = wid >> 1;
    const float Ah = -__expf(A_log[h]);
    LAS float* sct = (LAS float*)lds; LAS float* dect = (LAS float*)(lds + 32768);
    LAS unsigned char* img = lds + 33280;
    { float dtv[16];
#pragma unroll
      for (int i = 0; i < 16; ++i) dtv[i] = DT[((size_t)b * SEQ + (size_t)(wid + 8 * i) * 64 + lane) * 16 + h];
#pragma unroll
      for (int i = 0; i < 16; ++i) { const int c = wid + 8 * i;
        float ac = dtv[i] * Ah;
#pragma unroll
        for (int o = 1; o < 64; o <<= 1) { const float t = __shfl_up(ac, o); if (lane >= o) ac += t; }
        const float tot = __shfl(ac, 63);
        sct[c * 64 + lane] = dtv[i] * __expf(tot - ac);
        if (lane == 0) dect[c] = __expf(tot); } }
    __syncthreads();
    const int lX = tid >> 3, p8 = (tid & 7) * 8, lB = tid >> 3, n4 = (tid & 7) * 4;
    const bf16* xsrc = XBC + ((size_t)b * SEQ + lX) * XBCW + h * 64 + p8;
    const bf16* bsrc = XBC + ((size_t)b * SEQ + lB) * XBCW + 1024 + g * 128 + nq * 32 + n4;
    const size_t cstep = (size_t)64 * XBCW;
    LAS unsigned char* xw = img + lX * S1_XROW + p8 * 2;
    LAS unsigned char* bw = img + 64 * S1_XROW + lB * S1_BROW + n4 * 2;
    const LAS unsigned char* xtr = img + (8 * fq + (fr >> 2)) * S1_XROW + 32 * pt + (fr & 3) * 8;
    const LAS unsigned char* btr = img + 64 * S1_XROW + (8 * fq + (fr >> 2)) * S1_BROW + 32 * nt + (fr & 3) * 8;
    bf16* sp = ST + (((((size_t)b * 128) * 16 + h) * 4 + nq) * 64 + (16 * pt + fr)) * 32 + 16 * nt + 4 * fq;
    f32x4 hst = {0.f, 0.f, 0.f, 0.f};
    v4u Ax0, Ax1, Ax2, Ax3, Bx0, Bx1, Bx2, Bx3; u32x2v Ab0, Ab1, Ab2, Ab3, Bb0, Bb1, Bb2, Bb3;
#define S1_LOAD(k, R) do { const size_t o_ = (size_t)(4 * (k)) * cstep; \
        R##x0 = *(const GAS v4u*)(xsrc + o_); R##x1 = *(const GAS v4u*)(xsrc + o_ + cstep); R##x2 = *(const GAS v4u*)(xsrc + o_ + 2 * cstep); R##x3 = *(const GAS v4u*)(xsrc + o_ + 3 * cstep); \
        R##b0 = *(const GAS u32x2v*)(bsrc + o_); R##b1 = *(const GAS u32x2v*)(bsrc + o_ + cstep); R##b2 = *(const GAS u32x2v*)(bsrc + o_ + 2 * cstep); R##b3 = *(const GAS u32x2v*)(bsrc + o_ + 3 * cstep); } while (0)
#define S1_STAGE(k, R) do { const int bo_ = ((k) & 1) * 4 * S1_BUF; const int c_ = 4 * (k); \
        const float s0_ = sct[c_ * 64 + lX], s1_ = sct[(c_ + 1) * 64 + lX], s2_ = sct[(c_ + 2) * 64 + lX], s3_ = sct[(c_ + 3) * 64 + lX]; \
        *(LAS v4u*)(xw + bo_) = scale8(R##x0, s0_); *(LAS v4u*)(xw + bo_ + S1_BUF) = scale8(R##x1, s1_); *(LAS v4u*)(xw + bo_ + 2 * S1_BUF) = scale8(R##x2, s2_); *(LAS v4u*)(xw + bo_ + 3 * S1_BUF) = scale8(R##x3, s3_); \
        *(LAS u32x2v*)(bw + bo_) = R##b0; *(LAS u32x2v*)(bw + bo_ + S1_BUF) = R##b1; *(LAS u32x2v*)(bw + bo_ + 2 * S1_BUF) = R##b2; *(LAS u32x2v*)(bw + bo_ + 3 * S1_BUF) = R##b3; } while (0)
#define S1_MM(off, acc) do { _Pragma("unroll") for (int kl = 0; kl < 2; ++kl) { \
        const s16x4 a0 = vtr(btr + (off) + kl * 32 * S1_BROW), a1 = vtr(btr + (off) + kl * 32 * S1_BROW + 4 * S1_BROW), x0 = vtr(xtr + (off) + kl * 32 * S1_XROW), x1 = vtr(xtr + (off) + kl * 32 * S1_XROW + 4 * S1_XROW); \
        const bf16x8 af = __builtin_shufflevector(a0, a1, 0, 1, 2, 3, 4, 5, 6, 7), xf = __builtin_shufflevector(x0, x1, 0, 1, 2, 3, 4, 5, 6, 7); \
        acc = MFMA16(af, xf, acc); } } while (0)
#define S1_OUT(c) do { u32x2v o2; o2.x = cvtpk_s(hst[0], hst[1]); o2.y = cvtpk_s(hst[2], hst[3]); *(GAS u32x2v*)(sp + (size_t)(c) * (16 * 64 * 128)) = o2; } while (0)
#define S1_COMPUTE(k) do { const int bo_ = ((k) & 1) * 4 * S1_BUF; const int c_ = 4 * (k); \
        f32x4 sa_ = {0.f, 0.f, 0.f, 0.f}, sb_ = sa_, sc_ = sa_, sd_ = sa_; S1_MM(bo_, sa_); S1_MM(bo_ + S1_BUF, sb_); S1_MM(bo_ + 2 * S1_BUF, sc_); S1_MM(bo_ + 3 * S1_BUF, sd_); \
        const float d0_ = dect[c_], d1_ = dect[c_ + 1], d2_ = dect[c_ + 2], d3_ = dect[c_ + 3]; \
        S1_OUT(c_); hst = hst * d0_ + sa_; S1_OUT(c_ + 1); hst = hst * d1_ + sb_; S1_OUT(c_ + 2); hst = hst * d2_ + sc_; S1_OUT(c_ + 3); hst = hst * d3_ + sd_; } while (0)
#define S1_BAR() asm volatile("s_waitcnt lgkmcnt(0)\n\ts_barrier" ::: "memory")
    S1_LOAD(0, A); S1_LOAD(1, B);
    S1_STAGE(0, A); S1_LOAD(2, A);
    S1_BAR();
    for (int i = 0; i < 32; i += 2) {
        S1_STAGE(i + 1, B); if (i + 3 < 32) S1_LOAD(i + 3, B);
        S1_COMPUTE(i); S1_BAR();
        if (i + 2 < 32) { S1_STAGE(i + 2, A); if (i + 4 < 32) S1_LOAD(i + 4, A); }
        S1_COMPUTE(i + 1); S1_BAR();
    }
#undef S1_OUT
#undef S1_LOAD
#undef S1_STAGE
#undef S1_MM
#undef S1_COMPUTE
#undef S1_BAR
    __syncthreads();
}
__device__ __forceinline__ void s2_unit(LAS unsigned char* lds, const bf16* XBC, const float* DT, const float* A_log, const float* Dskip, const float* normw, const bf16* ST, bf16* ZY, int b, int c, int g, bool do_store) {
    const int tid = threadIdx.x, lane = tid & 63, fr = lane & 15, fq = lane >> 4; const int wid = __builtin_amdgcn_readfirstlane(tid >> 6);
    const int h = g * 8 + wid;
    const size_t row0 = (size_t)b * SEQ + (size_t)c * 64;
    LAS bf16* Cs = (LAS bf16*)lds; LAS bf16* Bs = (LAS bf16*)(lds + 17408); LAS unsigned char* Xi = lds + 34816 + wid * 9216;
    LAS float* acs = (LAS float*)(lds + 108544 + wid * 256); LAS float* dtl = (LAS float*)(lds + 110592 + wid * 256); LAS float* ssq = (LAS float*)(lds + 112640);
    const float Ah = -__expf(A_log[h]);
    v4u cv[2], bv[2], xv[8]; bf16x8 hf[4][4];
#pragma unroll
    for (int i = 0; i < 2; ++i) { const int idx = tid + 512 * i, l = idx >> 4, n8 = (idx & 15) * 8;
        cv[i] = *(const GAS v4u*)(XBC + (row0 + l) * XBCW + 1280 + g * 128 + n8); bv[i] = *(const GAS v4u*)(XBC + (row0 + l) * XBCW + 1024 + g * 128 + n8); }
    const float dtv = DT[(row0 + lane) * 16 + h];
#pragma unroll
    for (int i = 0; i < 8; ++i) xv[i] = *(const GAS v4u*)(XBC + (row0 + 8 * i + (lane >> 3)) * XBCW + h * 64 + (lane & 7) * 8);
    { const bf16* hp = ST + ((((size_t)b * 128 + c) * 16 + h) * 64) * 128;
#pragma unroll
      for (int kn = 0; kn < 4; ++kn)
#pragma unroll
          for (int pt = 0; pt < 4; ++pt) hf[kn][pt] = *(const GAS bf16x8*)(hp + (size_t)((kn * 64 + 16 * pt + fr) * 32 + 8 * fq)); }
#pragma unroll
    for (int i = 0; i < 2; ++i) { const int idx = tid + 512 * i, l = idx >> 4, n8 = (idx & 15) * 8; *(LAS v4u*)(Cs + l * LDC + n8) = cv[i]; *(LAS v4u*)(Bs + l * LDC + n8) = bv[i]; }
    { float ac = dtv * Ah;
#pragma unroll
      for (int o = 1; o < 64; o <<= 1) { const float t = __shfl_up(ac, o); if (lane >= o) ac += t; }
      acs[lane] = ac; dtl[lane] = dtv; }
#pragma unroll
    for (int i = 0; i < 8; ++i) *(LAS v4u*)(Xi + (8 * i + (lane >> 3)) * 144 + (lane & 7) * 16) = xv[i];
    __syncthreads();
    u32x2v zr[4][4];
#pragma unroll
    for (int lt = 0; lt < 4; ++lt)
#pragma unroll
        for (int pt = 0; pt < 4; ++pt) zr[lt][pt] = *(const GAS u32x2v*)(ZY + (row0 + 16 * lt + fr) * DM + h * 64 + 16 * pt + 4 * fq);
    f32x4 acc[4][4];
#pragma unroll
    for (int pt = 0; pt < 4; ++pt)
#pragma unroll
        for (int lt = 0; lt < 4; ++lt) acc[pt][lt] = (f32x4){0.f, 0.f, 0.f, 0.f};
#pragma unroll
    for (int kn = 0; kn < 4; ++kn) {
        bf16x8 cf[4];
#pragma unroll
        for (int lt = 0; lt < 4; ++lt) cf[lt] = *(const LAS bf16x8*)(Cs + (16 * lt + fr) * LDC + 32 * kn + 8 * fq);
#pragma unroll
        for (int pt = 0; pt < 4; ++pt)
#pragma unroll
            for (int lt = 0; lt < 4; ++lt) acc[pt][lt] = MFMA16(hf[kn][pt], cf[lt], acc[pt][lt]); }
#pragma unroll
    for (int lt = 0; lt < 4; ++lt) { const float ea = __expf(acs[16 * lt + fr]);
#pragma unroll
        for (int pt = 0; pt < 4; ++pt) acc[pt][lt] *= ea; }
    const LAS unsigned char* xtr = Xi + (4 * fq + (fr >> 2)) * 144 + (fr & 3) * 8;
#pragma unroll
    for (int lt = 0; lt < 4; ++lt) { const int l = 16 * lt + fr; const float al = acs[l];
#pragma unroll
        for (int sp = 0; sp < 2; ++sp) { if (2 * sp <= lt) {
            f32x4 cb0 = {0.f, 0.f, 0.f, 0.f}, cb1 = {0.f, 0.f, 0.f, 0.f};
#pragma unroll
            for (int kn = 0; kn < 4; ++kn) { const bf16x8 cfr = *(const LAS bf16x8*)(Cs + (16 * lt + fr) * LDC + 32 * kn + 8 * fq);
                const bf16x8 b0 = *(const LAS bf16x8*)(Bs + (32 * sp + fr) * LDC + 32 * kn + 8 * fq), b1 = *(const LAS bf16x8*)(Bs + (32 * sp + 16 + fr) * LDC + 32 * kn + 8 * fq);
                cb0 = MFMA16(b0, cfr, cb0); cb1 = MFMA16(b1, cfr, cb1); }
            float g0[4], g1[4];
#pragma unroll
            for (int r = 0; r < 4; ++r) { const int s0 = 32 * sp + 4 * fq + r, s1 = s0 + 16;
                const float e0 = __expf(al - acs[s0]) * dtl[s0], e1 = __expf(al - acs[s1]) * dtl[s1];
                g0[r] = (s0 <= l) ? cb0[r] * e0 : 0.f; g1[r] = (s1 <= l) ? cb1[r] * e1 : 0.f; }
            v4u gw; gw.x = cvtpk_s(g0[0], g0[1]); gw.y = cvtpk_s(g0[2], g0[3]); gw.z = cvtpk_s(g1[0], g1[1]); gw.w = cvtpk_s(g1[2], g1[3]);
            const bf16x8 gf = __builtin_bit_cast(bf16x8, gw);
#pragma unroll
            for (int pt = 0; pt < 4; ++pt) { const s16x4 a0 = vtr(xtr + (32 * sp) * 144 + 32 * pt), a1 = vtr(xtr + (32 * sp + 16) * 144 + 32 * pt);
                acc[pt][lt] = MFMA16(__builtin_shufflevector(a0, a1, 0, 1, 2, 3, 4, 5, 6, 7), gf, acc[pt][lt]); }
        } } }
    const float Dh = Dskip[h];
#pragma unroll
    for (int lt = 0; lt < 4; ++lt) { const int l = 16 * lt + fr; float ss = 0.f;
#pragma unroll
        for (int pt = 0; pt < 4; ++pt) { const int p0 = 16 * pt + 4 * fq;
            const u32x2v xr = *(const LAS u32x2v*)(Xi + l * 144 + p0 * 2), zz = zr[lt][pt];
            const float xs[4] = {bflo(xr.x), bfhi(xr.x), bflo(xr.y), bfhi(xr.y)}, zs[4] = {bflo(zz.x), bfhi(zz.x), bflo(zz.y), bfhi(zz.y)};
#pragma unroll
            for (int r = 0; r < 4; ++r) { float y = acc[pt][lt][r] + Dh * xs[r]; y *= silu_f(zs[r]); acc[pt][lt][r] = y; ss += y * y; } }
        ss += __shfl_xor(ss, 16); ss += __shfl_xor(ss, 32);
        if (fq == 0) ssq[wid * 64 + l] = ss; }
    __syncthreads();
#pragma unroll
    for (int lt = 0; lt < 4; ++lt) { const int l = 16 * lt + fr; float tot = 0.f;
#pragma unroll
        for (int w = 0; w < 8; ++w) tot += ssq[w * 64 + l];
        const float rs = 1.0f / sqrtf(tot * (1.f / 512.f) + RMS_EPS);
#pragma unroll
        for (int pt = 0; pt < 4; ++pt) { const int p0 = 16 * pt + 4 * fq; const f32x4 nw = *(const GAS f32x4*)(normw + h * 64 + p0);
            u32x2v o; o.x = cvtpk_s(acc[pt][lt][0] * rs * nw[0], acc[pt][lt][1] * rs * nw[1]); o.y = cvtpk_s(acc[pt][lt][2] * rs * nw[2], acc[pt][lt][3] * rs * nw[3]);
            if (do_store) *(GAS u32x2v*)(ZY + (row0 + l) * DM + h * 64 + p0) = o; else asm volatile("" :: "v"(o)); } }
    __syncthreads();
}
}

namespace naive {
__device__ __forceinline__ void conv_oop(Frame& F, const bf16* RAW, bf16* DST, const float* conv_w, const float* conv_b) {
    const int NIT = TOK * 192;
    for (int item = F.vcu * 512 + F.tid; item < NIT; item += F.G * 512) {
        const int row = item / 192, ch0 = (item - row * 192) * 8, t = row & (SEQ - 1);
        float y[8];
#pragma unroll
        for (int e = 0; e < 8; ++e) y[e] = conv_b[ch0 + e];
#pragma unroll
        for (int j = 0; j < 4; ++j) { const int tt = t - 3 + j; if (tt >= 0) { const v4u raw = *(const GAS v4u*)(RAW + (size_t)(row - 3 + j) * XBCW + ch0);
            const float c[8] = {bflo(raw.x), bfhi(raw.x), bflo(raw.y), bfhi(raw.y), bflo(raw.z), bfhi(raw.z), bflo(raw.w), bfhi(raw.w)};
#pragma unroll
            for (int e = 0; e < 8; ++e) y[e] += conv_w[j * XBCW + ch0 + e] * c[e]; } }
        v4u o; o.x = cvtpk_s(silu_f(y[0]), silu_f(y[1])); o.y = cvtpk_s(silu_f(y[2]), silu_f(y[3])); o.z = cvtpk_s(silu_f(y[4]), silu_f(y[5])); o.w = cvtpk_s(silu_f(y[6]), silu_f(y[7]));
        *(GAS v4u*)(DST + (size_t)row * XBCW + ch0) = o;
    }
}
__device__ __forceinline__ void ssd_seq(Frame& F, const bf16* XC, const float* DT, const float* A_log, const float* Dskip, const float* normw, bf16* ZY) {
    LAS float* red = (LAS float*)(F.lds + RING_OFF);
    for (int u = F.vcu; u < NB * NGRP; u += F.G) {
        const int b = u >> 1, g = u & 1, h = g * 8 + F.wave, p = F.lane;
        const float Ah = -__expf(A_log[h]), Dh = Dskip[h], nw = normw[h * 64 + p];
        float hs[128];
#pragma unroll
        for (int n = 0; n < 128; ++n) hs[n] = 0.f;
        for (int t = 0; t < SEQ; ++t) {
            const size_t row = (size_t)b * SEQ + t;
            const float dt = DT[row * 16 + h];
            const float dec = __expf(dt * Ah);
            const float xv = bflo((unsigned)XC[row * XBCW + h * 64 + p]);
            const float dx = dt * xv;
            float y = 0.f;
#pragma unroll
            for (int n8 = 0; n8 < 16; ++n8) {
                const v4u bw = *(const GAS v4u*)(XC + row * XBCW + 1024 + g * 128 + n8 * 8), cw = *(const GAS v4u*)(XC + row * XBCW + 1280 + g * 128 + n8 * 8);
                const float bb[8] = {bflo(bw.x), bfhi(bw.x), bflo(bw.y), bfhi(bw.y), bflo(bw.z), bfhi(bw.z), bflo(bw.w), bfhi(bw.w)};
                const float cc[8] = {bflo(cw.x), bfhi(cw.x), bflo(cw.y), bfhi(cw.y), bflo(cw.z), bfhi(cw.z), bflo(cw.w), bfhi(cw.w)};
#pragma unroll
                for (int e = 0; e < 8; ++e) { hs[n8 * 8 + e] = hs[n8 * 8 + e] * dec + dx * bb[e]; y += cc[e] * hs[n8 * 8 + e]; }
            }
            y += Dh * xv;
            const float zv = bflo((unsigned)ZY[row * DM + h * 64 + p]);
            y *= silu_f(zv);
            const float ss = wave_sum(y * y);
            if (F.lane == 0) red[(t & 1) * 8 + F.wave] = ss;
            __syncthreads();
            float tot = 0.f;
#pragma unroll
            for (int w = 0; w < 8; ++w) tot += red[(t & 1) * 8 + w];
            const float rs = 1.0f / sqrtf(tot * (1.f / 512.f) + RMS_EPS);
            ZY[row * DM + h * 64 + p] = (bf16)f2bf(y * rs * nw);
        }
        __syncthreads();
    }
}
__device__ __forceinline__ void attn_seq(Frame& F, const bf16* Q, const bf16* K, const bf16* V, bf16* O, const float* rel_bias) {
    for (int item = F.vcu * 512 + F.tid; item < TOK * NH; item += F.G * 512) {
        const int row = item >> 4, h = item & 15, t = row & (SEQ - 1), b = row >> 13;
        float q[64], acc[64];
#pragma unroll
        for (int d8 = 0; d8 < 8; ++d8) { const v4u w = *(const GAS v4u*)(Q + (size_t)row * DM + h * 64 + d8 * 8);
            q[d8 * 8 + 0] = bflo(w.x); q[d8 * 8 + 1] = bfhi(w.x); q[d8 * 8 + 2] = bflo(w.y); q[d8 * 8 + 3] = bfhi(w.y); q[d8 * 8 + 4] = bflo(w.z); q[d8 * 8 + 5] = bfhi(w.z); q[d8 * 8 + 6] = bflo(w.w); q[d8 * 8 + 7] = bfhi(w.w); }
#pragma unroll
        for (int d = 0; d < 64; ++d) acc[d] = 0.f;
        float m = -INFINITY, l = 0.f;
        const int c = t >> 6; int j0 = (c - 8) * 64; if (j0 < 0) j0 = 0; const int j1 = c * 64 + 64;
        for (int j = j0; j < j1; ++j) {
            const size_t kr = (size_t)b * SEQ + j;
            float s = 0.f;
#pragma unroll
            for (int d8 = 0; d8 < 8; ++d8) { const v4u w = *(const GAS v4u*)(K + kr * DM + h * 64 + d8 * 8);
                s += q[d8 * 8 + 0] * bflo(w.x) + q[d8 * 8 + 1] * bfhi(w.x) + q[d8 * 8 + 2] * bflo(w.y) + q[d8 * 8 + 3] * bfhi(w.y) + q[d8 * 8 + 4] * bflo(w.z) + q[d8 * 8 + 5] * bfhi(w.z) + q[d8 * 8 + 6] * bflo(w.w) + q[d8 * 8 + 7] * bfhi(w.w); }
            int rel = t - j; rel = rel < -128 ? -128 : (rel > 128 ? 128 : rel);
            s += rel_bias[h * 257 + rel + 128] * LOG2E;
            const float mn = fmaxf(m, s), al = __builtin_amdgcn_exp2f(m - mn), pw = __builtin_amdgcn_exp2f(s - mn);
            m = mn; l = l * al + pw;
#pragma unroll
            for (int d8 = 0; d8 < 8; ++d8) { const v4u w = *(const GAS v4u*)(V + kr * DM + h * 64 + d8 * 8);
                acc[d8 * 8 + 0] = acc[d8 * 8 + 0] * al + pw * bflo(w.x); acc[d8 * 8 + 1] = acc[d8 * 8 + 1] * al + pw * bfhi(w.x); acc[d8 * 8 + 2] = acc[d8 * 8 + 2] * al + pw * bflo(w.y); acc[d8 * 8 + 3] = acc[d8 * 8 + 3] * al + pw * bfhi(w.y);
                acc[d8 * 8 + 4] = acc[d8 * 8 + 4] * al + pw * bflo(w.z); acc[d8 * 8 + 5] = acc[d8 * 8 + 5] * al + pw * bfhi(w.z); acc[d8 * 8 + 6] = acc[d8 * 8 + 6] * al + pw * bflo(w.w); acc[d8 * 8 + 7] = acc[d8 * 8 + 7] * al + pw * bfhi(w.w); }
        }
        const float inv = 1.0f / l;
#pragma unroll
        for (int d8 = 0; d8 < 8; ++d8) { v4u o; o.x = cvtpk_s(acc[d8 * 8 + 0] * inv, acc[d8 * 8 + 1] * inv); o.y = cvtpk_s(acc[d8 * 8 + 2] * inv, acc[d8 * 8 + 3] * inv); o.z = cvtpk_s(acc[d8 * 8 + 4] * inv, acc[d8 * 8 + 5] * inv); o.w = cvtpk_s(acc[d8 * 8 + 6] * inv, acc[d8 * 8 + 7] * inv);
            *(GAS v4u*)(O + (size_t)row * DM + h * 64 + d8 * 8) = o; }
    }
}
}

namespace chk {
constexpr int CW_FLAG = 2048;
__device__ __forceinline__ float bfr(float w) { return __uint_as_float(f2bf(w) << 16); }
__device__ __forceinline__ float ldb(const bf16* p) { return __uint_as_float(((unsigned)*p) << 16); }
__device__ __forceinline__ float dotw(const bf16* Arow, const float* W, int N, int col, int K, int lane) {
    float s = 0.f; for (int k = lane; k < K; k += 64) s += ldb(Arow + k) * bfr(W[(size_t)k * N + col]); return wave_sum(s);
}
__device__ __forceinline__ void flag(Frame& F, int bit, bool bad) { if (bad && F.lane == 0) atomicOr((unsigned*)(F.ctl + CW_FLAG), 1u << bit); }
__device__ __forceinline__ bool far(float got, float want, float rel, float abs_) { const float e = fabsf(got - want); return !(e <= rel * fabsf(want) + abs_); }
__device__ __forceinline__ void pick(Frame& F, int N, int salt, int& row, int& col) {
    const unsigned gw = (unsigned)(F.vcu * NWAVES + F.wave); unsigned h = (gw + 1u) * 2654435761u + (unsigned)salt * 40503u; h ^= h >> 15; h *= 2246822519u; h ^= h >> 13;
    row = (int)(h % (unsigned)TOK); col = (int)((h >> 8) % (unsigned)N);
}
__device__ __forceinline__ void c_up(Frame& F, int bit, const bf16* XN, const float* wgu, const bf16* ACT) {
    int row, col; pick(F, FF, bit, row, col);
    const float g = dotw(XN + (size_t)row * DM, wgu, 2 * FF, col, DM, F.lane), u = dotw(XN + (size_t)row * DM, wgu, 2 * FF, FF + col, DM, F.lane);
    flag(F, bit, far(ldb(ACT + (size_t)row * FF + col), silu_f(g) * u, 0.03f, 0.01f));
}
__device__ __forceinline__ void c_down(Frame& F, int bit, const float* base, const bf16* ACT, const float* wd, const float* out) {
    int row, col; pick(F, DM, bit, row, col);
    const float d = dotw(ACT + (size_t)row * FF, wd, DM, col, FF, F.lane);
    flag(F, bit, far(out[(size_t)row * DM + col], base[(size_t)row * DM + col] + 0.5f * d, 0.f, 0.02f));
}
__device__ __forceinline__ void c_norm(Frame& F, int bit, const float* src, const float* w, const bf16* XN) {
    int row, col; pick(F, DM, bit, row, col);
    float s = 0.f; for (int k = F.lane; k < DM; k += 64) { const float v = src[(size_t)row * DM + k]; s += v * v; } s = wave_sum(s);
    const float want = src[(size_t)row * DM + col] / sqrtf(s / DM + RMS_EPS) * w[col];
    flag(F, bit, far(ldb(XN + (size_t)row * DM + col), want, 0.02f, 0.01f));
}
__device__ __forceinline__ void c_in1(Frame& F, int bit, const bf16* XN, const float* win, const bf16* Z, const bf16* XBC, const bf16* Q, const bf16* K, const bf16* V, const float* DT, const float* dt_bias) {
    int row, sc; pick(F, 5648, bit, row, sc);
    const float d = dotw(XN + (size_t)row * DM, win, 7696, sc, DM, F.lane);
    float got, want = d;
    if (sc < 1024) got = ldb(Z + (size_t)row * DM + sc);
    else if (sc < 2560) got = ldb(XBC + (size_t)row * XBCW + (sc - 1024));
    else if (sc < 2576) { got = DT[(size_t)row * 16 + (sc - 2560)]; const float xx = d + dt_bias[sc - 2560]; want = fmaxf(xx, 0.f) + log1pf(__expf(-fabsf(xx))); }
    else if (sc < 3600) { got = ldb(Q + (size_t)row * DM + (sc - 2576)); want = d * QSCALE; }
    else if (sc < 4624) got = ldb(K + (size_t)row * DM + (sc - 3600));
    else got = ldb(V + (size_t)row * DM + (sc - 4624));
    flag(F, bit, far(got, want, 0.03f, 0.02f));
}
__device__ __forceinline__ void c_gate(Frame& F, int bit, const bf16* XN, const float* win, const bf16* G) {
    int row, col; pick(F, NGATE, bit, row, col);
    const float d = dotw(XN + (size_t)row * DM, win, 7696, 5648 + col, DM, F.lane);
    const bool bad = far(ldb(G + (size_t)row * NGATE + col), sigm_f(d), 0.02f, 0.01f);
    flag(F, bit, bad);
}
__device__ __forceinline__ void c_merge(Frame& F, int bit, const bf16* YS, const bf16* YA, const bf16* G, const float* wbs, const float* wba, const bf16* MG) {
    int row, col; pick(F, DM, bit, row, col);
    const float a = dotw(YS + (size_t)row * DM, wbs, DM, col, DM, F.lane), c = dotw(YA + (size_t)row * DM, wba, DM, col, DM, F.lane);
    const float want = ldb(G + (size_t)row * NGATE + col) * a + ldb(G + (size_t)row * NGATE + DM + col) * c;
    flag(F, bit, far(ldb(MG + (size_t)row * DM + col), want, 0.03f, 0.02f));
}
__device__ __forceinline__ void c_wt(Frame& F, const float* win, const bf16* Wt) {
    int k, j; pick(F, NGATE, 77, k, j); k &= (DM - 1);
    unsigned bad = 0;
    for (int kk = F.lane; kk < DM; kk += 64) { const float want = bfr(win[(size_t)kk * 7696 + 5648 + j]); const float got = ldb(Wt + (size_t)(5888 + j) * DM + kk); if (got != want) bad = 1; }
    bad = (unsigned)(__ballot(bad) != 0ull);
    if (bad && F.lane == 0) atomicAdd((unsigned*)(F.ctl + CW_FLAG + 64), 1u);
}
}

struct Args { const float* in[20]; float* out; unsigned char* ws; int ph_lo, ph_hi, li, pad; };
__global__ void __launch_bounds__(NWAVES * 64, 2) fwd_kernel(Args args) {
    extern __shared__ __attribute__((aligned(16))) unsigned char lds[];
    Frame F;
    F.lds = (LAS unsigned char*)lds;
    F.MISC = (volatile LAS unsigned*)(F.lds + MISC_OFF);
    F.tid = threadIdx.x; F.lane = F.tid & 63; F.wave = __builtin_amdgcn_readfirstlane(F.tid >> 6);
    F.G = gridDim.x; { const int bx = blockIdx.x; F.vcu = (F.G % 8 == 0) ? (bx % 8) * (F.G / 8) + bx / 8 : bx; }
    unsigned char* ws = args.ws;
    F.ctl = (gu32*)(ws + WS_CTL);
    for (int u = F.tid; u < (LDS_BYTES - LDSCTL_OFF) / 4; u += NWAVES * 64) ((LAS unsigned*)(F.lds + LDSCTL_OFF))[u] = 0u;
    __syncthreads();
    XcdBarrier bar; bar.bar = (unsigned*)(F.ctl + CW_BAR); bar.x = 0; bar.st = nullptr;
    if (N_LAUNCHES == 1) bar = xcd_barrier_post((unsigned*)(F.ctl + CW_BAR), F.MISC + 8);
#define GRID_BAR() do { if (N_LAUNCHES == 1) xcd_barrier(bar); } while (0)
    const float* x = args.in[0]; float* out = args.out;
    bf16* Wgu1 = (bf16*)(ws + WS_WGU1); bf16* Wd1 = (bf16*)(ws + WS_WD1); bf16* Win = (bf16*)(ws + WS_WIN); bf16* Wbs = (bf16*)(ws + WS_WBS); bf16* Wba = (bf16*)(ws + WS_WBA);
    bf16* Wout = (bf16*)(ws + WS_WOUT); bf16* Wgu2 = (bf16*)(ws + WS_WGU2); bf16* Wd2 = (bf16*)(ws + WS_WD2);
    bf16* XN = (bf16*)(ws + WS_XN); bf16* ZB = (bf16*)(ws + WS_Z); bf16* XBC = (bf16*)(ws + WS_XBC); bf16* QB = (bf16*)(ws + WS_Q); bf16* KB = (bf16*)(ws + WS_K); bf16* VB = (bf16*)(ws + WS_V);
    float* DT = (float*)(ws + WS_DT); bf16* HALO = (bf16*)(ws + WS_HALO); bf16* ACT = (bf16*)(ws + WS_ACT); bf16* ST = (bf16*)(ws + WS_ST); bf16* GB = (bf16*)(ws + WS_G); bf16* MS = (bf16*)(ws + WS_MS);
    float* SS1 = (float*)(ws + WS_CTL + 262144); float* SS2 = (float*)(ws + WS_CTL + 393216);
    const int lo = args.ph_lo, hi = args.ph_hi;
#define IN(k) (lo <= (k) && (k) < hi)
#define SEAM(k) do { if (IN(k) && IN((k) + ((k) == 2 || (k) == 11 ? 2 : 1))) GRID_BAR(); } while (0)
    const int bx = (int)blockIdx.x;
#if PROBE_A
    unsigned long long* TS = (unsigned long long*)(ws + WS_CTL + 655360); int nts = 0;
#define STAMP() do { if (blockIdx.x == 0 && F.tid == 0) __hip_atomic_store(TS + nts, (unsigned long long)__builtin_amdgcn_s_memrealtime(), __ATOMIC_RELAXED, __HIP_MEMORY_SCOPE_AGENT); ++nts; } while (0)
    STAMP();
#else
#define STAMP() do {} while (0)
#endif

    if (IN(0)) { P0Args a{x, args.in[1], args.in[2], args.in[3], args.in[5], args.in[13], args.in[14], args.in[15], args.in[17], args.in[18], Wgu1, Wd1, Win, Wbs, Wba, Wout, Wgu2, Wd2, XN};
#if DUP_P0 == 0
        p0_prologue(F, a);
#else
        p0_prologue(F, a, DUP_P0); GRID_BAR(); p0_prologue(F, a);
#endif
        }
    SEAM(0); STAMP();
#if DBG_CHK
    if (IN(1)) chk::c_norm(F, 0, x, args.in[1], XN);
    if (IN(2)) chk::c_up(F, 1, XN, args.in[2], ACT);
    if (IN(3)) chk::c_down(F, 2, x, ACT, args.in[3], out);
    if (IN(4)) chk::c_norm(F, 3, out, args.in[4], XN);
    if (IN(5)) chk::c_in1(F, 4, XN, args.in[5], ZB, XBC, QB, KB, VB, DT, args.in[8]);
    if (IN(9)) { chk::c_gate(F, 5, XN, args.in[5], GB); chk::c_wt(F, args.in[5], Win); }
    if (IN(11)) chk::c_merge(F, 6, ZB, QB, GB, args.in[13], args.in[14], XN);
    if (IN(13)) chk::c_norm(F, 7, out, args.in[16], XN);
    if (IN(14)) chk::c_up(F, 8, XN, args.in[17], ACT);
#endif
    if (IN(1)) { pg8::Gemm g{XN, Wgu1, TOK, 2 * FF, DM}; pg8::StaticOrder S; S.init(TOK, 2 * FF, F.G, bx); pg8::EpiSwiglu E{ACT, nullptr};
        pg8::gemm_phase<pg8::EpiSwiglu, pg8::StaticOrder, true, true>(F.lds + RING_OFF, g, S, E); }
    SEAM(1); STAMP();
    if (IN(2)) { pg8::Gemm g{ACT, Wd1, TOK, DM, FF}; pg8::StaticOrder S; S.init(TOK, DM, F.G, bx); pg8::EpiResidNorm E{x, out, 0.5f, XN, args.in[4], SS1};
        pg8::gemm_phase<pg8::EpiResidNorm, pg8::StaticOrder, true, true>(F.lds + RING_OFF, g, S, E); }
    SEAM(2); STAMP();
    if (IN(4)) { pg8::Gemm g{XN, Win, TOK, NIN1, DM}; pg8::StaticOrder S; S.init(TOK, NIN1, F.G, bx); pg8::EpiIn1 E{ZB, XBC, QB, KB, VB, HALO, DT, args.in[8], SS1};
        pg8::gemm_phase<pg8::EpiIn1, pg8::StaticOrder, true, true>(F.lds + RING_OFF, g, S, E); }
    SEAM(4); STAMP();
    if (IN(5)) {
#if !DBG_SSD
#if DUP_CONV
        conv_pass(F, XBC, HALO, args.in[6], args.in[7], args.pad == 777);
#endif
        conv_pass(F, XBC, HALO, args.in[6], args.in[7], true);
#endif
#if DBG_ATT
        naive::attn_seq(F, QB, KB, VB, QB, args.in[12]);
#else
#if DUP_ATT
        att::attn_phase(F, QB, KB, VB, QB, args.in[12], args.pad == 777);
#endif
        att::attn_phase(F, QB, KB, VB, QB, args.in[12], true);
#endif
    }
    SEAM(5); STAMP();
#if DBG_SSD
    if (IN(6)) naive::conv_oop(F, XBC, KB, args.in[6], args.in[7]);
#else
    if (IN(6)) { for (int u = F.vcu; u < NB * NH * 4; u += F.G) ssd::s1_unit(F.lds + RING_OFF, XBC, DT, args.in[9], ST, u >> 6, (u >> 2) & 15, u & 3); }
#endif
    SEAM(6); STAMP();
#if DBG_SSD
    if (IN(7)) naive::ssd_seq(F, KB, DT, args.in[9], args.in[10], args.in[11], ZB);
#else
    if (IN(7)) {
#if DUP_S2
        for (int u = F.vcu; u < NB * 128 * NGRP; u += F.G) ssd::s2_unit(F.lds + RING_OFF, XBC, DT, args.in[9], args.in[10], args.in[11], ST, ZB, u >> 8, (u >> 1) & 127, u & 1, args.pad == 777);
#endif
        for (int u = F.vcu; u < NB * 128 * NGRP; u += F.G) ssd::s2_unit(F.lds + RING_OFF, XBC, DT, args.in[9], args.in[10], args.in[11], ST, ZB, u >> 8, (u >> 1) & 127, u & 1, true); }
#endif
    SEAM(7); STAMP();
    if (IN(8)) { pg8::Gemm g{XN, Win + (size_t)NIN1 * DM, TOK, NGATE, DM}; pg8::StaticOrder S; S.init(TOK, NGATE, F.G, bx); pg8::EpiGate E{GB, SS1};
        pg8::gemm_phase<pg8::EpiGate, pg8::StaticOrder, true, true>(F.lds + RING_OFF, g, S, E); }
    SEAM(8); STAMP();
    if (IN(9)) { pg8::Gemm g{ZB, Wbs, TOK, DM, DM}; pg8::StaticOrder S; S.init(TOK, DM, F.G, bx); pg8::EpiMerge<false> E{GB, nullptr, MS};
        pg8::gemm_phase<pg8::EpiMerge<false>, pg8::StaticOrder, true, true>(F.lds + RING_OFF, g, S, E); }
    if (IN(10)) { pg8::Gemm g{QB, Wba, TOK, DM, DM}; pg8::StaticOrder S; S.init(TOK, DM, F.G, bx); pg8::EpiMerge<true> E{GB + DM, MS, MS};
        pg8::gemm_phase<pg8::EpiMerge<true>, pg8::StaticOrder, true, true>(F.lds + RING_OFF, g, S, E); }
    SEAM(10); STAMP();
    if (IN(11)) { pg8::Gemm g{MS, Wout, TOK, DM, DM}; pg8::StaticOrder S; S.init(TOK, DM, F.G, bx); pg8::EpiResidNorm E{out, out, 1.0f, XN, args.in[16], SS2};
        pg8::gemm_phase<pg8::EpiResidNorm, pg8::StaticOrder, true, true>(F.lds + RING_OFF, g, S, E); }
    SEAM(11); STAMP();
    if (IN(13)) { pg8::Gemm g{XN, Wgu2, TOK, 2 * FF, DM}; pg8::StaticOrder S; S.init(TOK, 2 * FF, F.G, bx); pg8::EpiSwiglu E{ACT, SS2};
        pg8::gemm_phase<pg8::EpiSwiglu, pg8::StaticOrder, true, true>(F.lds + RING_OFF, g, S, E); }
    SEAM(13); STAMP();
    if (IN(14)) { pg8::Gemm g{ACT, Wd2, TOK, DM, FF}; pg8::StaticOrder S; S.init(TOK, DM, F.G, bx); pg8::EpiResid E{out, out, 0.5f};
        pg8::gemm_phase<pg8::EpiResid, pg8::StaticOrder, true, true>(F.lds + RING_OFF, g, S, E); }
    SEAM(14); STAMP();
    if (IN(15)) { const int gw = F.vcu * NWAVES + F.wave, NGW = F.G * NWAVES; for (int m = gw; m < TOK; m += NGW) rms_row_f32_inplace(F.lane, out + (size_t)m * DM, args.in[19]);
#if PROBE_A
        { const float ta = (float)(__hip_atomic_load(TS + PROBE_A, RLX_AGENT) - __hip_atomic_load(TS + PROBE_A - 1, RLX_AGENT)) * 0.01f, tr = (float)(__hip_atomic_load(TS + PROBE_R, RLX_AGENT) - __hip_atomic_load(TS + PROBE_R - 1, RLX_AGENT)) * 0.01f;
          const float sc = 1.0f + tr * 0.001f;
          for (int m = gw; m < TOK; m += NGW) { GAS f32x4* xr = (GAS f32x4*)(out + (size_t)m * DM) + F.lane; for (int j = 0; j < 4; ++j) xr[64 * j] = xr[64 * j] * sc; }
          if (gw == 0 && F.lane == 0) { asm volatile("s_waitcnt vmcnt(0)" ::: "memory"); out[0] = out[0] + ta; } }
#endif
#if DBG_CHK
        { const unsigned fl = __hip_atomic_load(F.ctl + chk::CW_FLAG, RLX_AGENT); const unsigned cnt = __hip_atomic_load(F.ctl + chk::CW_FLAG + 64, RLX_AGENT); const float sc = 1.0f + 0.5f * (float)(cnt ? 32 - __builtin_clz(cnt) : (fl ? __builtin_ctz(fl) + 1 : 0));
          for (int m = gw; m < TOK; m += NGW) { GAS f32x4* xr = (GAS f32x4*)(out + (size_t)m * DM) + F.lane; for (int j = 0; j < 4; ++j) xr[64 * j] = xr[64 * j] * sc; } }
#endif
    }
#undef IN
#undef SEAM
#undef GRID_BAR
}

extern "C" void kernel_launch(void* const* d_in, const int* in_sizes, int n_in, void* d_out, int out_size, void* d_ws, size_t ws_size, hipStream_t stream) {
    static int grid = 0;
    if (grid == 0) {
        if (n_in != 20 || in_sizes[0] != TOK * DM || out_size != TOK * DM || ws_size < WS_END) { fprintf(stderr, "kernel_launch: unexpected shapes (n_in %d, in0 %d, out %d, ws %zu)\n", n_in, n_in > 0 ? in_sizes[0] : -1, out_size, ws_size); grid = -1; return; }
        int dev = 0, cus = 0, per_cu = 0;
        if (hipGetDevice(&dev) != hipSuccess || hipDeviceGetAttribute(&cus, hipDeviceAttributeMultiprocessorCount, dev) != hipSuccess) { grid = -1; return; }
        if (hipFuncSetAttribute((const void*)fwd_kernel, hipFuncAttributeMaxDynamicSharedMemorySize, LDS_BYTES) != hipSuccess) { fprintf(stderr, "kernel_launch: hipFuncSetAttribute failed\n"); grid = -1; return; }
        if (hipOccupancyMaxActiveBlocksPerMultiprocessor(&per_cu, (const void*)fwd_kernel, NWAVES * 64, LDS_BYTES) != hipSuccess || per_cu < 1) { fprintf(stderr, "kernel_launch: occupancy query says %d\n", per_cu); per_cu = 1; }
        (void)hipGetLastError();
        grid = cus;
    }
    if (grid < 0) return;
    if (hipMemsetAsync((char*)d_ws + WS_CTL, 0, CTL_ZERO_BYTES, stream) != hipSuccess) { fprintf(stderr, "kernel_launch: memset failed\n"); return; }
    Args a{};
    for (int i = 0; i < 20; ++i) a.in[i] = (const float*)d_in[i];
    a.out = (float*)d_out; a.ws = (unsigned char*)d_ws;
    if (N_LAUNCHES == 1) {
        a.ph_lo = 0; a.ph_hi = N_PHASES; a.li = 0;
        void* kargs[] = {&a};
        hipError_t e = hipLaunchCooperativeKernel((const void*)fwd_kernel, dim3(grid), dim3(NWAVES * 64), kargs, LDS_BYTES, stream);
        if (e != hipSuccess) fprintf(stderr, "kernel_launch: cooperative launch failed: %s (grid %d)\n", hipGetErrorString(e), grid);
    } else {
        for (int li = 0; li < N_PHASES; ++li) {
            a.ph_lo = li; a.ph_hi = li + 1; a.li = li;
            hipLaunchKernelGGL(fwd_kernel, dim3(grid), dim3(NWAVES * 64), LDS_BYTES, stream, a);
        }
    }
}
```
